# Optimizing an MI355X kernel written in HIP

```python
import jax, jax.numpy as jnp
from jax import lax
import numpy as np

D_MODEL = 1024
BATCH = 8
SEQ = 4096
DEPTH = 2

CHUNK = 64
MIX_WIDTH = D_MODEL
ATT_HEADS = 8
ATT_HEAD_DIM = 64
ATT_WIDTH = ATT_HEADS * ATT_HEAD_DIM
LEFT_CHUNKS = 8
BAND = (LEFT_CHUNKS + 1) * CHUNK
REL_CLIP = 256
RET_HEADS = 4
RET_HEAD_DIM = 128
RET_WIDTH = RET_HEADS * RET_HEAD_DIM
SPLIT_WIDTHS = (ATT_WIDTH, ATT_WIDTH, ATT_WIDTH, ATT_WIDTH,
                RET_WIDTH, RET_WIDTH, RET_WIDTH, RET_WIDTH)
IN_WIDTH = sum(SPLIT_WIDTHS)
EPS = 1e-6
ROPE_BASE = 10000.0
NEG_INF = -1e30

kernel_name = "hybrid_chunked_attn_retention"


def rms_norm(x, gain=None):
    xf = x.astype(jnp.float32)
    y = xf * lax.rsqrt(jnp.mean(xf * xf, axis=-1, keepdims=True) + EPS)
    if gain is not None:
        y = y * gain.astype(jnp.float32)
    return y.astype(x.dtype)


def rotary_tables(positions, dim):
    inv_freq = 1.0 / (ROPE_BASE ** jnp.linspace(0.0, 1.0, dim // 2, dtype=jnp.float32))
    ang = positions.astype(jnp.float32)[:, None] * inv_freq[None, :]
    return jnp.cos(ang), jnp.sin(ang)


def apply_rotary(t, cos, sin):
    t1, t2 = jnp.split(t, 2, axis=-1)
    c = cos[None, :, None, :]
    s = sin[None, :, None, :]
    return jnp.concatenate([t1 * c - t2 * s, t1 * s + t2 * c], axis=-1)


def chunked_rel_attention(q, k, v, rel_bias):
    b, s, h, dh = q.shape
    nc = s // CHUNK
    qc = q.astype(jnp.float32).reshape(b, nc, CHUNK, h, dh)
    pad = ((0, 0), (LEFT_CHUNKS * CHUNK, 0), (0, 0), (0, 0))
    kp = jnp.pad(k.astype(jnp.float32), pad).reshape(b, nc + LEFT_CHUNKS, CHUNK, h, dh)
    vp = jnp.pad(v.astype(jnp.float32), pad).reshape(b, nc + LEFT_CHUNKS, CHUNK, h, dh)
    kb = jnp.concatenate([kp[:, j:j + nc] for j in range(LEFT_CHUNKS + 1)], axis=2)
    vb = jnp.concatenate([vp[:, j:j + nc] for j in range(LEFT_CHUNKS + 1)], axis=2)
    scores = jnp.einsum("bnqhd,bnkhd->bnhqk", qc, kb) * (dh ** -0.5)
    q_off = jnp.arange(CHUNK)[:, None] + LEFT_CHUNKS * CHUNK
    k_off = jnp.arange(BAND)[None, :]
    dist = q_off - k_off
    bias = rel_bias.astype(jnp.float32)[:, jnp.clip(dist, -REL_CLIP, REL_CLIP) + REL_CLIP]
    key_pos = (jnp.arange(nc)[:, None] - LEFT_CHUNKS) * CHUNK + k_off
    valid = (key_pos >= 0)[None, :, None, None, :]
    scores = jnp.where(valid, scores + bias[None, None], NEG_INF)
    p = jax.nn.softmax(scores, axis=-1)
    out = jnp.einsum("bnhqk,bnkhd->bnqhd", p, vb)
    return out.reshape(b, s, h * dh)


def chunkwise_retention(q, k, v, cos, sin):
    b, s, h, dk = q.shape
    dv = v.shape[-1]
    nc = s // CHUNK
    q = apply_rotary(q.astype(jnp.float32), cos, sin)
    k = apply_rotary(k.astype(jnp.float32), cos, sin) * (dk ** -0.5)
    v = v.astype(jnp.float32)
    log_g = jnp.log1p(-jnp.exp2(-5.0 - jnp.arange(h, dtype=jnp.float32)))
    idx = jnp.arange(CHUNK, dtype=jnp.float32)
    intra_decay = jnp.exp(jnp.abs(idx[:, None] - idx[None, :])[None] * log_g[:, None, None])
    k_decay = jnp.exp((CHUNK - 1 - idx)[None, :] * log_g[:, None])
    q_decay = jnp.exp((idx + 1.0)[None, :] * log_g[:, None])
    chunk_decay = jnp.exp(CHUNK * log_g)
    qc = q.reshape(b, nc, CHUNK, h, dk)
    kc = k.reshape(b, nc, CHUNK, h, dk)
    vc = v.reshape(b, nc, CHUNK, h, dv)
    att = jnp.einsum("bnihd,bnjhd->bnhij", qc, kc) * intra_decay[None, None]
    o_intra = jnp.einsum("bnhij,bnjhe->bnihe", att, vc)
    kv = jnp.einsum("bnjhd,hj,bnjhe->bnhde", kc, k_decay, vc)

    def step(state, kv_n):
        return state * chunk_decay[None, :, None, None] + kv_n, state

    _, states = lax.scan(step, jnp.zeros((b, h, dk, dv), jnp.float32), jnp.moveaxis(kv, 1, 0))
    states = jnp.moveaxis(states, 0, 1)
    o_inter = jnp.einsum("bnihd,hi,bnhde->bnihe", qc, q_decay, states)
    o = rms_norm(o_intra + o_inter)
    return o.reshape(b, s, h * dv)


def hybrid_layer(x, norm_gain, w_in, w_out, rel_bias, cos, sin):
    b, s, _ = x.shape
    hn = rms_norm(x, norm_gain)
    proj = hn @ w_in.astype(hn.dtype)
    cuts = list(np.cumsum(SPLIT_WIDTHS)[:-1])
    aq, ak, av, ag, rq, rk, rv, rg = jnp.split(proj, cuts, axis=-1)
    ya = chunked_rel_attention(aq.reshape(b, s, ATT_HEADS, ATT_HEAD_DIM),
                               ak.reshape(b, s, ATT_HEADS, ATT_HEAD_DIM),
                               av.reshape(b, s, ATT_HEADS, ATT_HEAD_DIM), rel_bias)
    yr = chunkwise_retention(rq.reshape(b, s, RET_HEADS, RET_HEAD_DIM),
                             rk.reshape(b, s, RET_HEADS, RET_HEAD_DIM),
                             rv.reshape(b, s, RET_HEADS, RET_HEAD_DIM), cos, sin)
    y = jnp.concatenate([ya * jax.nn.silu(ag.astype(jnp.float32)),
                         yr * jax.nn.silu(rg.astype(jnp.float32))], axis=-1).astype(x.dtype)
    return x + y @ w_out.astype(x.dtype)


def setup_inputs(seed: int = 0) -> dict:
    key = jax.random.key(seed)
    kx, kg, ki, ko, kb, kf = jax.random.split(key, 6)
    x = jax.random.normal(kx, (BATCH, SEQ, D_MODEL), jnp.float32)
    positions = jnp.arange(SEQ, dtype=jnp.int32)
    norm_gain = 1.0 + 0.02 * jax.random.normal(kg, (DEPTH, D_MODEL), jnp.float32)
    w_in = jax.random.normal(ki, (DEPTH, D_MODEL, IN_WIDTH), jnp.float32) * D_MODEL ** -0.5
    w_out = jax.random.normal(ko, (DEPTH, MIX_WIDTH, D_MODEL), jnp.float32) * MIX_WIDTH ** -0.5
    rel_bias = 0.1 * jax.random.normal(kb, (DEPTH, ATT_HEADS, 2 * REL_CLIP + 1), jnp.float32)
    final_gain = 1.0 + 0.02 * jax.random.normal(kf, (D_MODEL,), jnp.float32)
    return {"x": x, "positions": positions, "norm_gain": norm_gain, "w_in": w_in,
            "w_out": w_out, "rel_bias": rel_bias, "final_gain": final_gain}


def reference(x, positions, norm_gain, w_in, w_out, rel_bias, final_gain):
    cos, sin = rotary_tables(positions, RET_HEAD_DIM)
    for layer in range(DEPTH):
        x = hybrid_layer(x, norm_gain[layer], w_in[layer], w_out[layer], rel_bias[layer], cos, sin)
    return rms_norm(x, final_gain)
```

```cpp
#include <hip/hip_runtime.h>
#include <hip/hip_cooperative_groups.h>
#include <cstdio>
#include <cstdint>
namespace cg = cooperative_groups;
namespace pg8 {
#define PG8_LAS __attribute__((address_space(3)))
typedef unsigned short bf16_t;
typedef short bf16x8 __attribute__((ext_vector_type(8)));
typedef float f32x4 __attribute__((ext_vector_type(4)));
typedef unsigned u32x4 __attribute__((ext_vector_type(4)));
constexpr int BM = 256, BK = 64, HALF = 128, HTB = HALF * BK * 2  , STAGE_BYTES = 8 * HTB, NXCD = 8, WGM = 8;

__host__ __device__ __forceinline__ int lds_byte(int r, int c) { const int st = (r >> 4) * 2 + (c >> 5), rr = r & 15, cc = c & 31, ob = rr * 64 + cc * 2; return st * 1024 + (ob ^ (((ob >> 9) & 1) << 5)); }
__host__ __device__ __forceinline__ void stage_rc(int b, int& R, int& C) { const int st = b / 1024, sb = b % 1024, swz = sb ^ (((sb >> 9) & 1) << 5); R = (st >> 1) * 16 + swz / 64; C = (st & 1) * 32 + (swz % 64) / 2; }
__host__ __device__ __forceinline__ int perm32(int rho) { const int n = rho >> 4, i = rho & 15; return 8 * (i >> 2) + 4 * n + (i & 3); }

struct Unit { int pm, pn; };
struct Gemm { const bf16_t* A; const bf16_t* Bt; int M, N, K; };

struct StaticOrder {
    int nM, nN, nwg, G, c;
    __host__ __device__ void init(int M, int N, int G_, int c_) { nM = M / BM; nN = N / BM; nwg = nM * nN; G = G_; c = c_; }
    __host__ __device__ bool next(int i, Unit& u) const {
        const long L = (long)i * G + c; if (L >= nwg) return false;
        int wgid = (int)L; { const int q = nwg / NXCD, r = nwg % NXCD, xcd = wgid % NXCD, off = wgid / NXCD; wgid = (xcd < r ? xcd * (q + 1) : r * (q + 1) + (xcd - r) * q) + off; }
        const int nig = WGM * nN, gid = wgid / nig, fm = gid * WGM, gsz = (nM - fm) < WGM ? (nM - fm) : WGM;
        u.pm = fm + ((wgid % nig) % gsz); u.pn = (wgid % nig) / gsz; return true;
    }
    __device__ __forceinline__ void a_ready(const Unit&) const {}
    __device__ __forceinline__ void done(const Unit&) const {}
};

__device__ __forceinline__ unsigned cvt_pk_bf16(float lo, float hi) { unsigned r; asm volatile("v_cvt_pk_bf16_f32 %0, %1, %2" : "=v"(r) : "v"(lo), "v"(hi)); return r; }
typedef float f32x2 __attribute__((ext_vector_type(2)));
__device__ __forceinline__ f32x2 gelu_pk(f32x2 v) {
    const f32x2 av = __builtin_elementwise_abs(v), d = av * 0.2316418882f + 1.0f;
    f32x2 t; t.x = __builtin_amdgcn_rcpf(d.x); t.y = __builtin_amdgcn_rcpf(d.y);
    f32x2 q = t * 0.5307027145f + (-0.7265760135f); q = q * t + 0.7107068705f; q = q * t + (-0.142248368f); q = q * t + 0.127414796f; q = q * t;
    const f32x2 s = (v * v) * (-0.72134752044f);
    f32x2 e; e.x = __builtin_amdgcn_exp2f(s.x); e.y = __builtin_amdgcn_exp2f(s.y);
    const f32x2 m = v * (q * e), r = v - m;
    f32x2 o; o.x = v.x < 0.f ? m.x : r.x; o.y = v.y < 0.f ? m.y : r.y; return o;
}

template <int ACT  > struct EpiBf16 {
    static constexpr bool PERM = true, AFTER_DRAIN = false; static_assert(ACT == 0 || ACT == 1, "EpiBf16: ACT is 0 (none) or 1 (gelu_pk)");
    bf16_t* O; int ldc; const float* bias; int split_cols; size_t split_stride; float scale0;
    __device__ __forceinline__ void operator()(const f32x4 (&acc)[2][2][4][2], const Unit& u, int wr, int wc, int fr, int fq) const {
        const int row0 = u.pm * BM + wr * 64 + fr; int colt = u.pn * BM; bf16_t* base = O;
        float sc = 1.f; if (split_cols) { const int t = colt / split_cols; base += (size_t)t * split_stride; colt -= t * split_cols; if (t == 0) sc = scale0; }
        const int col0 = colt + wc * 32 + 8 * fq, bcol0 = u.pn * BM + wc * 32 + 8 * fq;
        f32x4 bv[2][2];
#pragma unroll
        for (int bj = 0; bj < 2; ++bj)
#pragma unroll
            for (int n = 0; n < 2; ++n) bv[bj][n] = bias ? *(const f32x4*)(bias + bcol0 + bj * HALF + 4 * n) : (f32x4){0.f, 0.f, 0.f, 0.f};
#pragma unroll
        for (int ai = 0; ai < 2; ++ai)
#pragma unroll
            for (int m = 0; m < 4; ++m) { bf16_t* rowp = base + (size_t)(row0 + ai * HALF + m * 16) * ldc + col0;
#pragma unroll
                for (int bj = 0; bj < 2; ++bj) { f32x4 v0 = acc[ai][bj][m][0] + bv[bj][0], v1 = acc[ai][bj][m][1] + bv[bj][1];
                    if (ACT == 1) { f32x2 a = gelu_pk((f32x2){v0[0], v0[1]}), b = gelu_pk((f32x2){v0[2], v0[3]}), c = gelu_pk((f32x2){v1[0], v1[1]}), d = gelu_pk((f32x2){v1[2], v1[3]});
                        v0 = (f32x4){a.x, a.y, b.x, b.y}; v1 = (f32x4){c.x, c.y, d.x, d.y}; }
                    v0 = v0 * sc; v1 = v1 * sc; u32x4 w; w.x = cvt_pk_bf16(v0[0], v0[1]); w.y = cvt_pk_bf16(v0[2], v0[3]); w.z = cvt_pk_bf16(v1[0], v1[1]); w.w = cvt_pk_bf16(v1[2], v1[3]);
                    *(u32x4*)(rowp + bj * HALF) = w; } }
    }
};

struct PanelStats {
    unsigned* xbuf;
    unsigned* cnt;
    unsigned* tmo;
    int ntn; float eps;
    unsigned code;
    __device__ __forceinline__ bool run(const f32x4 (&v)[2][2][4][2], const Unit& u, int wr, int wc, int fr, int fq, PG8_LAS unsigned char* lds, int wid, int lane) const {
        typedef float f32x2v __attribute__((ext_vector_type(2)));
        PG8_LAS f32x2v* P = (PG8_LAS f32x2v*)lds;
        PG8_LAS f32x2v* S = (PG8_LAS f32x2v*)(lds + 8192);
        PG8_LAS unsigned* flag = (PG8_LAS unsigned*)(lds + 8192 + 2048);
#pragma unroll
        for (int ai = 0; ai < 2; ++ai)
#pragma unroll
            for (int m = 0; m < 4; ++m) {
                float s = 0.f;
#pragma unroll
                for (int bj = 0; bj < 2; ++bj)
#pragma unroll
                    for (int n = 0; n < 2; ++n) { const f32x4 x = v[ai][bj][m][n]; s += (x[0] + x[1]) + (x[2] + x[3]); }
                s += __shfl_xor(s, 16); s += __shfl_xor(s, 32);
                const float mw = s * (1.0f / 64.0f); float q = 0.f;
#pragma unroll
                for (int bj = 0; bj < 2; ++bj)
#pragma unroll
                    for (int n = 0; n < 2; ++n) { const f32x4 d = v[ai][bj][m][n] - mw; q += (d[0] * d[0] + d[1] * d[1]) + (d[2] * d[2] + d[3] * d[3]); }
                q += __shfl_xor(q, 16); q += __shfl_xor(q, 32);
                if (fq == 0) P[(ai * HALF + wr * 64 + m * 16 + fr) * 4 + wc] = (f32x2v){mw, q};
            }
        asm volatile("s_waitcnt lgkmcnt(0)" ::: "memory"); __builtin_amdgcn_s_barrier(); asm volatile("" ::: "memory");
#if defined(BROKEN_EXCHANGE_NO_WAIT)
#warning BROKEN CONTROL BUILD: the row-statistics exchange does not wait; results are wrong by design
        if (blockIdx.x >= 64) { const long long t0_ = clock64(); while (clock64() - t0_ < 60000) __builtin_amdgcn_s_sleep(8); }
#endif
        const int row = wid * 32 + (lane & 31);
        if (lane < 32) {
            const f32x2v a = P[row * 4 + 0], b = P[row * 4 + 1], c = P[row * 4 + 2], d = P[row * 4 + 3];
            const float mt = (a.x + b.x + c.x + d.x) * 0.25f;
            const float da = a.x - mt, db = b.x - mt, dc = c.x - mt, dd = d.x - mt;
            const float m2 = (a.y + b.y) + (c.y + d.y) + 64.0f * ((da * da + db * db) + (dc * dc + dd * dd));
            unsigned long long* slot = (unsigned long long*)xbuf + ((size_t)(u.pm * BM + row) * 4 + u.pn);
            __hip_atomic_store(slot, ((unsigned long long)__float_as_uint(m2) << 32) | __float_as_uint(mt), __ATOMIC_RELAXED, __HIP_MEMORY_SCOPE_AGENT);
        }
        asm volatile("s_waitcnt vmcnt(0)" ::: "memory");
        if (lane == 0) __hip_atomic_fetch_add(cnt + 64 * u.pm, 1u, __ATOMIC_RELAXED, __HIP_MEMORY_SCOPE_AGENT);
        if (wid == 0) {
            bool dead = false; const unsigned long long t0 = __builtin_amdgcn_s_memrealtime(); const unsigned want = 8u * (unsigned)ntn;
            for (;;) {
#if defined(BROKEN_EXCHANGE_NO_WAIT)
                break;
#endif
                if ((unsigned)__builtin_amdgcn_readfirstlane(__hip_atomic_load(cnt + 64 * u.pm, __ATOMIC_RELAXED, __HIP_MEMORY_SCOPE_AGENT)) >= want) break;
                if (__builtin_amdgcn_s_memrealtime() - t0 > 2000000ull) {
                    if (lane == 0) { unsigned expect = 0u; __hip_atomic_compare_exchange_strong(tmo + 1, &expect, code | (unsigned)(u.pm & 0xff), __ATOMIC_RELAXED, __ATOMIC_RELAXED, __HIP_MEMORY_SCOPE_AGENT);
                                     __hip_atomic_store(tmo, 1u, __ATOMIC_RELAXED, __HIP_MEMORY_SCOPE_AGENT); }
                    dead = true; break; }
                __builtin_amdgcn_s_sleep(2);
            }
            __builtin_amdgcn_fence(__ATOMIC_ACQUIRE, "agent");
            if (lane == 0) flag[0] = dead ? 1u : 0u;
        }
        asm volatile("s_waitcnt vmcnt(0) lgkmcnt(0)" ::: "memory"); __builtin_amdgcn_s_barrier(); asm volatile("" ::: "memory");
        const bool bad = flag[0] != 0u;
        if (lane < 32) {
            const unsigned long long* slot = (const unsigned long long*)xbuf + (size_t)(u.pm * BM + row) * 4; float mt[4], m2[4]; float ms = 0.f;
#pragma unroll
            for (int t = 0; t < 4; ++t) { if (t < ntn) { const unsigned long long w = __hip_atomic_load(slot + t, __ATOMIC_RELAXED, __HIP_MEMORY_SCOPE_AGENT); mt[t] = __uint_as_float((unsigned)w); m2[t] = __uint_as_float((unsigned)(w >> 32)); } else { mt[t] = 0.f; m2[t] = 0.f; } ms += mt[t]; }
            const float mean = ms / (float)ntn; float q = 0.f;
#pragma unroll
            for (int t = 0; t < 4; ++t) if (t < ntn) { const float dm = mt[t] - mean; q += m2[t] + 256.0f * dm * dm; }
            S[row] = (f32x2v){mean, 1.0f / sqrtf(q / (256.0f * (float)ntn) + eps)};
        }
        asm volatile("s_waitcnt lgkmcnt(0)" ::: "memory"); __builtin_amdgcn_s_barrier(); asm volatile("" ::: "memory");
        return bad;
    }
};
struct EpiLnRes {
    static constexpr bool PERM = false, AFTER_DRAIN = true;
    const float* base; float* out; int ldc; const float* bias; PanelStats st; unsigned poison;
    __device__ __forceinline__ void fused(f32x4 (&acc)[2][2][4][2], const Unit& u, int wr, int wc, int fr, int fq, PG8_LAS unsigned char* lds, int wid, int lane) const {
        typedef float f32x2v __attribute__((ext_vector_type(2)));
        const PG8_LAS f32x2v* S = (const PG8_LAS f32x2v*)(lds + 8192);
        const int col0 = u.pn * BM + wc * 32 + 4 * fq;
#pragma unroll
        for (int bj = 0; bj < 2; ++bj)
#pragma unroll
            for (int n = 0; n < 2; ++n) { const f32x4 bv = bias ? *(const f32x4*)(bias + col0 + bj * HALF + n * 16) : (f32x4){0.f, 0.f, 0.f, 0.f};
#pragma unroll
                for (int ai = 0; ai < 2; ++ai)
#pragma unroll
                    for (int m = 0; m < 4; ++m) acc[ai][bj][m][n] += bv; }
        f32x4 pre[4][2][2];
#pragma unroll
        for (int m = 0; m < 4; ++m) { const size_t off = (size_t)(u.pm * BM + wr * 64 + m * 16 + fr) * ldc + col0;
#pragma unroll
            for (int bj = 0; bj < 2; ++bj)
#pragma unroll
                for (int n = 0; n < 2; ++n) pre[m][bj][n] = *(const f32x4*)(base + off + bj * HALF + n * 16); }
        const bool bad = st.run(acc, u, wr, wc, fr, fq, lds, wid, lane) || poison != 0u;
        const float qnan = __builtin_nanf("");
#pragma unroll
        for (int ai = 0; ai < 2; ++ai)
#pragma unroll
            for (int m = 0; m < 4; ++m) { const int r = ai * HALF + wr * 64 + m * 16 + fr; const f32x2v sr = S[r]; const size_t off = (size_t)(u.pm * BM + r) * ldc + col0;
#pragma unroll
                for (int bj = 0; bj < 2; ++bj)
#pragma unroll
                    for (int n = 0; n < 2; ++n) { const f32x4 bs = ai == 0 ? pre[m][bj][n] : *(const f32x4*)(base + off + bj * HALF + n * 16); f32x4 o = bs + (acc[ai][bj][m][n] - sr.x) * sr.y;
                        if (bad) o = (f32x4){qnan, qnan, qnan, qnan}; *(f32x4*)(out + off + bj * HALF + n * 16) = o; }
                if (m & 1) asm volatile("" ::: "memory"); }
    }
};
struct EpiLnResLn {
    static constexpr bool PERM = false, AFTER_DRAIN = true;
    const float* base; float* out; bf16_t* xn; int ldc; const float* bias; PanelStats st1, st2; unsigned poison;
    __device__ __forceinline__ void fused(f32x4 (&acc)[2][2][4][2], const Unit& u, int wr, int wc, int fr, int fq, PG8_LAS unsigned char* lds, int wid, int lane) const {
        typedef float f32x2v __attribute__((ext_vector_type(2))); typedef unsigned u32x2v __attribute__((ext_vector_type(2)));
        const PG8_LAS f32x2v* S = (const PG8_LAS f32x2v*)(lds + 8192);
        const int col0 = u.pn * BM + wc * 32 + 4 * fq;
#pragma unroll
        for (int bj = 0; bj < 2; ++bj)
#pragma unroll
            for (int n = 0; n < 2; ++n) { const f32x4 bv = bias ? *(const f32x4*)(bias + col0 + bj * HALF + n * 16) : (f32x4){0.f, 0.f, 0.f, 0.f};
#pragma unroll
                for (int ai = 0; ai < 2; ++ai)
#pragma unroll
                    for (int m = 0; m < 4; ++m) acc[ai][bj][m][n] += bv; }
        bool bad = st1.run(acc, u, wr, wc, fr, fq, lds, wid, lane) || poison != 0u;
        const float qnan = __builtin_nanf("");
#pragma unroll
        for (int ai = 0; ai < 2; ++ai)
#pragma unroll
            for (int m = 0; m < 4; ++m) { const int r = ai * HALF + wr * 64 + m * 16 + fr; const f32x2v sr = S[r]; const size_t off = (size_t)(u.pm * BM + r) * ldc + col0;
#pragma unroll
                for (int bj = 0; bj < 2; ++bj)
#pragma unroll
                    for (int n = 0; n < 2; ++n) { const f32x4 bs = *(const f32x4*)(base + off + bj * HALF + n * 16); acc[ai][bj][m][n] = bs + (acc[ai][bj][m][n] - sr.x) * sr.y; }
                asm volatile("" : "+v"(acc[ai][0][m][0]), "+v"(acc[ai][0][m][1]), "+v"(acc[ai][1][m][0]), "+v"(acc[ai][1][m][1]));
                if (m & 1) asm volatile("" ::: "memory"); }
        const bool bad1 = bad;
        bad = st2.run(acc, u, wr, wc, fr, fq, lds, wid, lane) || bad;
#pragma unroll
        for (int ai = 0; ai < 2; ++ai)
#pragma unroll
            for (int m = 0; m < 4; ++m) { const int r = ai * HALF + wr * 64 + m * 16 + fr; const f32x2v sr = S[r]; const size_t off = (size_t)(u.pm * BM + r) * ldc + col0;
#pragma unroll
                for (int bj = 0; bj < 2; ++bj)
#pragma unroll
                    for (int n = 0; n < 2; ++n) { const f32x4 x1 = acc[ai][bj][m][n]; *(f32x4*)(out + off + bj * HALF + n * 16) = bad1 ? (f32x4){qnan, qnan, qnan, qnan} : x1;
                        const f32x4 o = (x1 - sr.x) * sr.y; u32x2v w; w.x = cvt_pk_bf16(o[0], o[1]); w.y = cvt_pk_bf16(o[2], o[3]);
                        if (bad) { w.x = 0x7fc07fc0u; w.y = 0x7fc07fc0u; } *(u32x2v*)(xn + off + bj * HALF + n * 16) = w; }
                asm volatile("" ::: "memory"); }
    }
};

template <class Epi, class Sched, bool ALIGN_EPI = false, bool SP2 = false>
__device__ __forceinline__ void gemm_phase(PG8_LAS unsigned char* lds, const Gemm g, const Sched& S, const Epi& E) {
    const int tid = threadIdx.x, wid = __builtin_amdgcn_readfirstlane(tid >> 6), lane = tid & 63, wr = wid >> 2, wc = wid & 3, fr = lane & 15, fq = lane >> 4;
    const int K = g.K, nt = K / BK;
    unsigned voffA[2], voffB[2];
#pragma unroll
    for (int i = 0; i < 2; ++i) { int R, C; stage_rc(tid * 16 + i * 8192, R, C); const int Rb = Epi::PERM ? ((R & ~31) + perm32(R & 31)) : R;
        voffA[i] = (unsigned)(R * K + C) * 2u; voffB[i] = (unsigned)(Rb * K + C) * 2u; }
    const size_t kstep = (size_t)(BK * 2);
    const size_t hstep = (size_t)HALF * K * 2;
    const size_t tstep = 2 * hstep;
    const unsigned ldsw = (unsigned)wid * 1024u;
    const int aoff = lds_byte(wr * 64 + fr, fq * 8), boff = lds_byte(wc * 32 + fr, fq * 8);
#define PG8_SA(b, h) (((b) * 2 + (h)) * HTB)
#define PG8_SB(b, h) ((4 + (b) * 2 + (h)) * HTB)
#define PG8_STAGE(bufoff, gbase, voff) do { _Pragma("unroll") for (int _i = 0; _i < 2; ++_i) \
        __builtin_amdgcn_global_load_lds((const unsigned*)((const char*)(gbase) + (voff)[_i]), (PG8_LAS unsigned*)(lds + (bufoff) + ldsw + _i * 8192), 16, 0, 0); } while (0)
#define PG8_LDA(dst, b, h) do { _Pragma("unroll") for (int m = 0; m < 4; ++m) _Pragma("unroll") for (int k = 0; k < 2; ++k) dst[m][k] = *(const PG8_LAS bf16x8*)(lds + PG8_SA(b, h) + aoff + m * 2048 + k * 1024); } while (0)
#define PG8_LDB(dst, b, h) do { _Pragma("unroll") for (int n = 0; n < 2; ++n) _Pragma("unroll") for (int k = 0; k < 2; ++k) dst[n][k] = *(const PG8_LAS bf16x8*)(lds + PG8_SB(b, h) + boff + n * 2048 + k * 1024); } while (0)
#define PG8_MMA(ai, bj, At, Bt) do { __builtin_amdgcn_s_setprio(1); _Pragma("unroll") for (int m = 0; m < 4; ++m) _Pragma("unroll") for (int n = 0; n < 2; ++n) _Pragma("unroll") for (int k = 0; k < 2; ++k) \
        acc[ai][bj][m][n] = __builtin_amdgcn_mfma_f32_16x16x32_bf16(Bt[n][k], At[m][k], acc[ai][bj][m][n], 0, 0, 0); __builtin_amdgcn_s_setprio(0); } while (0)
#define PG8_WAIT_V(n) asm volatile("s_waitcnt vmcnt(" #n ")" ::: "memory")
#define PG8_WAIT_L(n) asm volatile("s_waitcnt lgkmcnt(" #n ")" ::: "memory")
#define PG8_BAR __builtin_amdgcn_s_barrier()
#define PG8_SCHED __builtin_amdgcn_sched_barrier(0)
    Unit cur, nxt; int ui = 0;
    if (!S.next(0, cur)) return;
    f32x4 acc[2][2][4][2];
#pragma unroll
    for (int a = 0; a < 2; ++a)
#pragma unroll
        for (int b = 0; b < 2; ++b)
#pragma unroll
            for (int m = 0; m < 4; ++m)
#pragma unroll
                for (int n = 0; n < 2; ++n) acc[a][b][m][n] = (f32x4){0.f, 0.f, 0.f, 0.f};
    bf16x8 At[4][2], B0[2][2], B1[2][2];
    const char* cA = (const char*)g.A + (size_t)cur.pm * tstep; const char* cB = (const char*)g.Bt + (size_t)cur.pn * tstep;
    S.a_ready(cur);
    if constexpr (SP2) {
        PG8_STAGE(PG8_SB(0, 0), cB, voffB); PG8_STAGE(PG8_SB(0, 1), cB + hstep, voffB); PG8_STAGE(PG8_SA(0, 0), cA, voffA); PG8_STAGE(PG8_SA(0, 1), cA + hstep, voffA);
        if (wr == 1) PG8_BAR;
        PG8_WAIT_V(2); PG8_BAR;
        PG8_STAGE(PG8_SB(1, 0), cB + kstep, voffB); PG8_STAGE(PG8_SA(1, 0), cA + kstep, voffA); PG8_STAGE(PG8_SB(1, 1), cB + hstep + kstep, voffB);
        PG8_WAIT_V(6); PG8_BAR;
    } else {
        PG8_STAGE(PG8_SB(0, 0), cB, voffB); PG8_STAGE(PG8_SA(0, 0), cA, voffA); PG8_STAGE(PG8_SB(0, 1), cB + hstep, voffB); PG8_STAGE(PG8_SA(0, 1), cA + hstep, voffA);
        if (wr == 1) PG8_BAR;
        PG8_WAIT_V(4); PG8_BAR;
        PG8_STAGE(PG8_SB(1, 0), cB + kstep, voffB); PG8_STAGE(PG8_SA(1, 0), cA + kstep, voffA); PG8_STAGE(PG8_SB(1, 1), cB + hstep + kstep, voffB);
        PG8_WAIT_V(6); PG8_BAR;
    }
    for (;;) {
        const bool has_next = S.next(ui + 1, nxt);
        const char* nA = has_next ? (const char*)g.A + (size_t)nxt.pm * tstep : cA; const char* nB = has_next ? (const char*)g.Bt + (size_t)nxt.pn * tstep : cB;
        for (int t = 0; t < nt; t += 2) {
            const bool last = (t == nt - 2);
            const char* a1 = cA + (size_t)(t + 1) * kstep;
            const char* a2 = last ? nA : cA + (size_t)(t + 2) * kstep; const char* b2 = last ? nB : cB + (size_t)(t + 2) * kstep;
            const char* a3 = a2 + kstep; const char* b3 = b2 + kstep;
            if (last && has_next) S.a_ready(nxt);
            if constexpr (SP2) {
            PG8_LDB(B0, 0, 0); PG8_LDB(B1, 0, 1); PG8_SCHED; PG8_LDA(At, 0, 0); PG8_STAGE(PG8_SA(1, 1), a1 + hstep, voffA);
            PG8_WAIT_V(8); PG8_WAIT_L(0); PG8_BAR; PG8_MMA(0, 0, At, B0); PG8_MMA(0, 1, At, B1); PG8_BAR; PG8_SCHED;
            PG8_LDA(At, 0, 1); PG8_STAGE(PG8_SB(0, 0), b2, voffB); PG8_STAGE(PG8_SB(0, 1), b2 + hstep, voffB); PG8_STAGE(PG8_SA(0, 0), a2, voffA);
            PG8_WAIT_V(8); PG8_WAIT_L(0); PG8_BAR; PG8_MMA(1, 0, At, B0); PG8_MMA(1, 1, At, B1); PG8_BAR; PG8_SCHED;
            PG8_LDB(B0, 1, 0); PG8_LDB(B1, 1, 1); PG8_SCHED; PG8_LDA(At, 1, 0); PG8_STAGE(PG8_SA(0, 1), a2 + hstep, voffA);
            PG8_WAIT_V(8); PG8_WAIT_L(0); PG8_BAR; PG8_MMA(0, 0, At, B0); PG8_MMA(0, 1, At, B1); PG8_BAR; PG8_SCHED;
            PG8_LDA(At, 1, 1); PG8_STAGE(PG8_SB(1, 0), b3, voffB); PG8_STAGE(PG8_SB(1, 1), b3 + hstep, voffB); PG8_STAGE(PG8_SA(1, 0), a3, voffA);
            PG8_WAIT_V(8); PG8_WAIT_L(0); PG8_BAR; PG8_MMA(1, 0, At, B0); PG8_MMA(1, 1, At, B1); PG8_BAR; PG8_SCHED;
            } else {
            PG8_LDB(B0, 0, 0); PG8_SCHED; PG8_LDA(At, 0, 0); PG8_STAGE(PG8_SA(1, 1), a1 + hstep, voffA);
            PG8_WAIT_L(8); PG8_BAR; PG8_WAIT_L(0); PG8_MMA(0, 0, At, B0); PG8_BAR; PG8_SCHED;
            PG8_LDB(B1, 0, 1); PG8_STAGE(PG8_SB(0, 0), b2, voffB);
            PG8_BAR; PG8_WAIT_L(0); PG8_MMA(0, 1, At, B1); PG8_BAR;
            PG8_LDA(At, 0, 1); PG8_STAGE(PG8_SA(0, 0), a2, voffA);
            PG8_BAR; PG8_WAIT_L(0); PG8_MMA(1, 0, At, B0); PG8_BAR; PG8_SCHED;
            PG8_STAGE(PG8_SB(0, 1), b2 + hstep, voffB);
            PG8_WAIT_V(6); PG8_BAR; PG8_MMA(1, 1, At, B1); PG8_BAR;
            PG8_LDB(B0, 1, 0); PG8_SCHED; PG8_LDA(At, 1, 0); PG8_STAGE(PG8_SA(0, 1), a2 + hstep, voffA);
            PG8_WAIT_L(8); PG8_BAR; PG8_WAIT_L(0); PG8_MMA(0, 0, At, B0); PG8_BAR; PG8_SCHED;
            PG8_LDB(B1, 1, 1); PG8_STAGE(PG8_SB(1, 0), b3, voffB);
            PG8_BAR; PG8_WAIT_L(0); PG8_MMA(0, 1, At, B1); PG8_BAR;
            PG8_LDA(At, 1, 1); PG8_STAGE(PG8_SA(1, 0), a3, voffA);
            PG8_BAR; PG8_WAIT_L(0); PG8_MMA(1, 0, At, B0); PG8_BAR; PG8_SCHED;
            PG8_STAGE(PG8_SB(1, 1), b3 + hstep, voffB);
            PG8_WAIT_V(6); PG8_BAR; PG8_MMA(1, 1, At, B1); PG8_BAR;
            }
        }
        if constexpr (ALIGN_EPI) { if (wr == 0) PG8_BAR; }
        if constexpr (!Epi::AFTER_DRAIN) { E(acc, cur, wr, wc, fr, fq); S.done(cur); }
        if (!has_next) break;
#pragma unroll
        for (int a = 0; a < 2; ++a)
#pragma unroll
            for (int b = 0; b < 2; ++b)
#pragma unroll
                for (int m = 0; m < 4; ++m)
#pragma unroll
                    for (int n = 0; n < 2; ++n) acc[a][b][m][n] = (f32x4){0.f, 0.f, 0.f, 0.f};
        cur = nxt; cA = nA; cB = nB; ++ui;
        if constexpr (ALIGN_EPI) { if (wr == 1) PG8_BAR; }
    }
    PG8_WAIT_V(0);
    if constexpr (!ALIGN_EPI) { if (wr == 0) PG8_BAR; }
    PG8_BAR;
    if constexpr (Epi::AFTER_DRAIN) { E.fused(acc, cur, wr, wc, fr, fq, lds, wid, lane); S.done(cur); }
#undef PG8_SA
#undef PG8_SB
#undef PG8_STAGE
#undef PG8_LDA
#undef PG8_LDB
#undef PG8_MMA
#undef PG8_WAIT_V
#undef PG8_WAIT_L
#undef PG8_BAR
#undef PG8_SCHED
}
}

#ifndef PG8_SP2
#define PG8_SP2 true
#endif
#ifndef PG8_ALIGN
#define PG8_ALIGN true
#endif

#define LAS __attribute__((address_space(3)))
typedef unsigned short bf16_t;
typedef short bf16x8 __attribute__((ext_vector_type(8)));
typedef short s16x4 __attribute__((ext_vector_type(4)));
typedef float f32x4 __attribute__((ext_vector_type(4)));
typedef float f32x16 __attribute__((ext_vector_type(16)));
typedef unsigned u32x4 __attribute__((ext_vector_type(4)));
typedef unsigned u32x2 __attribute__((ext_vector_type(2)));
typedef float f32x2_t __attribute__((ext_vector_type(2)));
typedef __bf16 bf16x2_t __attribute__((ext_vector_type(2)));

#ifndef MK_MULTI
#define MK_MULTI 1
#endif

constexpr int BATCH = 8, SEQ = 4096, DM = 1024, DEPTH = 2, CHUNK = 64, NCH = SEQ / CHUNK, MTOK = BATCH * SEQ, INW = 4096;
constexpr int AH = 8, AD = 64, RH = 4, RD = 128, NREL = 513;
constexpr float EPS = 1e-6f, LOG2E = 1.4426950408889634f;
constexpr int NTHREADS = 512, NWAVES = 8;
constexpr int LDS_BYTES = 147456;

constexpr size_t MiB = 1u << 20;
constexpr size_t WS_WIN = 0;
constexpr size_t WS_WOUT = 16 * MiB;
constexpr size_t WS_ROT = 20 * MiB;
constexpr size_t WS_T = 22 * MiB;
constexpr size_t WS_HB = 64 * MiB;
constexpr size_t WS_PROJ = 128 * MiB;
constexpr size_t WS_END = 384 * MiB;

struct Args { const float* x; const int* pos; const float* ng; const float* win; const float* wout; const float* relb; const float* fg; float* out; unsigned char* ws; int ph_lo, ph_hi; };

__device__ __forceinline__ float bf2f(unsigned short u) { return __uint_as_float((unsigned)u << 16); }
__device__ __forceinline__ unsigned cvtpk(float lo, float hi) { f32x2_t v = {lo, hi}; bf16x2_t b = __builtin_convertvector(v, bf16x2_t); return __builtin_bit_cast(unsigned, b); }
__device__ __forceinline__ float ex2(float v) { return __builtin_amdgcn_exp2f(v); }
__device__ __forceinline__ float silu_f(float v) { return v / (1.0f + __expf(-v)); }
#define MFMA32(a, b, c) __builtin_amdgcn_mfma_f32_32x32x16_bf16((a), (b), (c), 0, 0, 0)
__device__ __forceinline__ int crow(int reg, int h) { return (reg & 3) + 8 * (reg >> 2) + 4 * h; }
__device__ __forceinline__ float wave_sum(float v) {
#pragma unroll
    for (int o = 1; o < 64; o <<= 1) v += __shfl_xor(v, o);
    return v;
}
__device__ __forceinline__ bf16x8 tr_frag(LAS const unsigned char* p, int d2) {
    const s16x4 lo = __builtin_bit_cast(s16x4, __builtin_amdgcn_ds_read_tr16_b64_v4i16((LAS s16x4*)p));
    const s16x4 hi = __builtin_bit_cast(s16x4, __builtin_amdgcn_ds_read_tr16_b64_v4i16((LAS s16x4*)(p + d2)));
    return (bf16x8){lo[0], lo[1], lo[2], lo[3], hi[0], hi[1], hi[2], hi[3]};
}
__device__ __forceinline__ bf16x8 pack8(const f32x16& x, int s) {
    u32x4 p; p.x = cvtpk(x[8 * s], x[8 * s + 1]); p.y = cvtpk(x[8 * s + 2], x[8 * s + 3]); p.z = cvtpk(x[8 * s + 4], x[8 * s + 5]); p.w = cvtpk(x[8 * s + 6], x[8 * s + 7]);
    return __builtin_bit_cast(bf16x8, p);
}

struct EpiProj {
    static constexpr bool PERM = true, AFTER_DRAIN = false;
    bf16_t* O;
    __device__ __forceinline__ void operator()(const pg8::f32x4 (&acc)[2][2][4][2], const pg8::Unit& u, int wr, int wc, int fr, int fq) const {
        const int row0 = u.pm * 256 + wr * 64 + fr; const int colt = u.pn * 256; const int seg = colt >> 9;
        const int col0 = colt + wc * 32 + 8 * fq;
        const float sc = seg == 0 ? 0.125f * LOG2E : (seg == 5 ? 0.08838834764831845f : 1.0f);
        const bool act = (seg == 3) || (seg == 7);
#pragma unroll
        for (int ai = 0; ai < 2; ++ai)
#pragma unroll
            for (int m = 0; m < 4; ++m) { bf16_t* rowp = O + (size_t)(row0 + ai * 128 + m * 16) * INW + col0;
#pragma unroll
                for (int bj = 0; bj < 2; ++bj) { pg8::f32x4 v0 = acc[ai][bj][m][0], v1 = acc[ai][bj][m][1];
                    if (act) {
#pragma unroll
                        for (int e = 0; e < 4; ++e) { v0[e] = silu_f(v0[e]); v1[e] = silu_f(v1[e]); } }
                    v0 = v0 * sc; v1 = v1 * sc;
                    u32x4 w; w.x = cvtpk(v0[0], v0[1]); w.y = cvtpk(v0[2], v0[3]); w.z = cvtpk(v1[0], v1[1]); w.w = cvtpk(v1[2], v1[3]);
                    *(u32x4*)(rowp + bj * 128) = w; } }
    }
};
struct EpiRes {
    static constexpr bool PERM = true, AFTER_DRAIN = false;
    const float* base; float* out;
    __device__ __forceinline__ void operator()(const pg8::f32x4 (&acc)[2][2][4][2], const pg8::Unit& u, int wr, int wc, int fr, int fq) const {
        const int row0 = u.pm * 256 + wr * 64 + fr; const int col0 = u.pn * 256 + wc * 32 + 8 * fq;
#pragma unroll
        for (int ai = 0; ai < 2; ++ai)
#pragma unroll
            for (int m = 0; m < 4; ++m) { const size_t off = (size_t)(row0 + ai * 128 + m * 16) * DM + col0;
#pragma unroll
                for (int bj = 0; bj < 2; ++bj) {
                    const f32x4 b0 = *(const f32x4*)(base + off + bj * 128), b1 = *(const f32x4*)(base + off + bj * 128 + 4);
                    f32x4 o0, o1;
#pragma unroll
                    for (int e = 0; e < 4; ++e) { o0[e] = b0[e] + acc[ai][bj][m][0][e]; o1[e] = b1[e] + acc[ai][bj][m][1][e]; }
                    *(f32x4*)(out + off + bj * 128) = o0; *(f32x4*)(out + off + bj * 128 + 4) = o1; } }
    }
};

__device__ __forceinline__ void transpose_item(const float* W, int K, int N, bf16_t* WT, LAS float* scr, int item, int lane) {
    const int nblk = N / 32, kb = item / nblk, nb = item % nblk, k0 = 64 * kb, n0 = 32 * nb;
#pragma unroll 8
    for (int i = 0; i < 32; ++i) { const int kk = 2 * i + (lane >> 5); scr[kk * 33 + (lane & 31)] = W[(size_t)(k0 + kk) * N + n0 + (lane & 31)]; }
    __builtin_amdgcn_wave_barrier();
    const int c = lane & 7;
#pragma unroll
    for (int j = 0; j < 4; ++j) { const int n = (lane >> 3) + 8 * j; const LAS float* s = scr + (8 * c) * 33 + n;
        u32x4 o; o.x = cvtpk(s[0 * 33], s[1 * 33]); o.y = cvtpk(s[2 * 33], s[3 * 33]); o.z = cvtpk(s[4 * 33], s[5 * 33]); o.w = cvtpk(s[6 * 33], s[7 * 33]);
        *(u32x4*)(WT + (size_t)(n0 + n) * K + k0 + 8 * c) = o; }
    __builtin_amdgcn_wave_barrier();
}
__device__ __forceinline__ void rms_row_bf16(const float* xrow, const float* gain, bf16_t* orow, int lane) {
    const f32x4* xr = (const f32x4*)xrow + lane; const f32x4* gr = (const f32x4*)gain + lane;
    f32x4 v[4]; float s = 0.f;
#pragma unroll
    for (int j = 0; j < 4; ++j) { v[j] = xr[64 * j]; s += (v[j][0] * v[j][0] + v[j][1] * v[j][1]) + (v[j][2] * v[j][2] + v[j][3] * v[j][3]); }
    const float rstd = 1.0f / sqrtf(wave_sum(s) * (1.0f / DM) + EPS);
    u32x2* o8 = (u32x2*)orow + lane;
#pragma unroll
    for (int j = 0; j < 4; ++j) { const f32x4 g = gr[64 * j]; u32x2 w; w.x = cvtpk(v[j][0] * rstd * g[0], v[j][1] * rstd * g[1]); w.y = cvtpk(v[j][2] * rstd * g[2], v[j][3] * rstd * g[3]); o8[64 * j] = w; }
}
__device__ __forceinline__ void rms_row_f32(const float* xrow, const float* gain, float* orow, int lane) {
    const f32x4* xr = (const f32x4*)xrow + lane; const f32x4* gr = (const f32x4*)gain + lane;
    f32x4 v[4]; float s = 0.f;
#pragma unroll
    for (int j = 0; j < 4; ++j) { v[j] = xr[64 * j]; s += (v[j][0] * v[j][0] + v[j][1] * v[j][1]) + (v[j][2] * v[j][2] + v[j][3] * v[j][3]); }
    const float rstd = 1.0f / sqrtf(wave_sum(s) * (1.0f / DM) + EPS);
    f32x4* o = (f32x4*)orow + lane;
#pragma unroll
    for (int j = 0; j < 4; ++j) { const f32x4 g = gr[64 * j]; f32x4 w; w[0] = v[j][0] * rstd * g[0]; w[1] = v[j][1] * rstd * g[1]; w[2] = v[j][2] * rstd * g[2]; w[3] = v[j][3] * rstd * g[3]; o[64 * j] = w; }
}
__device__ __forceinline__ void rot_entry(int pos, int j, float& c, float& s) {
    const float invf = (float)exp2(-(double)j * (13.287712379549449 / 63.0));
    const float ang = (float)pos * invf;
    const double x = (double)ang;
    const double k = rint(x * 0.15915494309189535);
    const double r = x - k * 6.283185307179586;
    const double r2 = r * r; double sp = 1.0, cp = 1.0;
#pragma unroll
    for (int n = 16; n >= 1; --n) { sp = 1.0 - sp * r2 * (1.0 / (double)((2 * n) * (2 * n + 1))); cp = 1.0 - cp * r2 * (1.0 / (double)((2 * n - 1) * (2 * n))); }
    s = (float)(r * sp); c = (float)cp;
}

constexpr int VP = 144;
constexpr int ATT_WAVE_LDS = 64 * VP + 320 * 4;
__device__ __forceinline__ void attn_unit(const bf16_t* __restrict__ proj, bf16_t* __restrict__ y, const float* __restrict__ relb, LAS unsigned char* wl, int b, int n, int h, int qh, int lane) {
    const int r = lane & 31, hi = lane >> 5;
    LAS float* biasL = (LAS float*)(wl + 64 * VP);
    __builtin_amdgcn_wave_barrier();
    for (int e = lane; e < 320; e += 64) biasL[e] = relb[h * NREL + 193 + e] * LOG2E;
    __builtin_amdgcn_wave_barrier();
    const size_t tq = (size_t)b * SEQ + n * 64 + qh * 32;
    bf16x8 qf[4];
    { const bf16_t* qp = proj + (tq + r) * INW + h * 64 + 8 * hi;
#pragma unroll
      for (int s = 0; s < 4; ++s) qf[s] = *(const bf16x8*)(qp + 16 * s); }
    f32x16 o0, o1;
#pragma unroll
    for (int i = 0; i < 16; ++i) { o0[i] = 0.f; o1[i] = 0.f; }
    float m = -1e30f, l = 0.f;
    const int qi = qh * 32 + r;
    const int j0 = n >= 8 ? 0 : 8 - n;
    const int i16 = lane & 15, tq_ = i16 >> 2, tp = i16 & 3, blk = (lane >> 4) & 1;
    LAS const unsigned char* vperm = wl + (4 * hi + tq_) * VP + (16 * blk + 4 * tp) * 2;
    for (int j = j0; j < 9; ++j) {
        const size_t kt = (size_t)b * SEQ + (size_t)(n - 8 + j) * 64;
        u32x4 vreg[8];
        { const bf16_t* vp = proj + (kt + (lane >> 3)) * INW + 1024 + h * 64 + (lane & 7) * 8;
#pragma unroll
          for (int it = 0; it < 8; ++it) vreg[it] = *(const u32x4*)(vp + (size_t)it * 8 * INW); }
        const bf16_t* kp = proj + (kt + r) * INW + 512 + h * 64 + 8 * hi;
        f32x16 s0, s1;
#pragma unroll
        for (int i = 0; i < 16; ++i) { s0[i] = 0.f; s1[i] = 0.f; }
#pragma unroll
        for (int s = 0; s < 4; ++s) { const bf16x8 k0 = *(const bf16x8*)(kp + 16 * s), k1 = *(const bf16x8*)(kp + (size_t)32 * INW + 16 * s);
            s0 = MFMA32(k0, qf[s], s0); s1 = MFMA32(k1, qf[s], s1); }
        const int dbase = qi + 512 - (j * 64 + 4 * hi);
        float mx = -1e30f;
#pragma unroll
        for (int reg = 0; reg < 16; ++reg) { const int d0 = dbase - ((reg & 3) + 8 * (reg >> 2)); const int d1 = d0 - 32;
            const int i0 = (d0 < 256 ? d0 : 256) + 63, i1 = (d1 < 256 ? d1 : 256) + 63;
            s0[reg] += biasL[i0]; s1[reg] += biasL[i1]; mx = fmaxf(mx, fmaxf(s0[reg], s1[reg])); }
        mx = fmaxf(mx, __shfl_xor(mx, 32));
        const float mnew = fmaxf(m, mx), alpha = ex2(m - mnew); m = mnew; l *= alpha;
        float ls = 0.f;
#pragma unroll
        for (int reg = 0; reg < 16; ++reg) { o0[reg] *= alpha; o1[reg] *= alpha; s0[reg] = ex2(s0[reg] - mnew); s1[reg] = ex2(s1[reg] - mnew); ls += s0[reg] + s1[reg]; }
        l += ls;
        bf16x8 pf[2][2]; pf[0][0] = pack8(s0, 0); pf[0][1] = pack8(s0, 1); pf[1][0] = pack8(s1, 0); pf[1][1] = pack8(s1, 1);
        __builtin_amdgcn_wave_barrier();
#pragma unroll
        for (int it = 0; it < 8; ++it) *(LAS u32x4*)(wl + (it * 8 + (lane >> 3)) * VP + (lane & 7) * 16) = vreg[it];
        __builtin_amdgcn_wave_barrier();
#pragma unroll
        for (int kb = 0; kb < 2; ++kb)
#pragma unroll
            for (int s2 = 0; s2 < 2; ++s2) {
                const bf16x8 v0 = tr_frag(vperm + (kb * 32 + 16 * s2) * VP, 8 * VP);
                const bf16x8 v1 = tr_frag(vperm + (kb * 32 + 16 * s2) * VP + 64, 8 * VP);
                o0 = MFMA32(v0, pf[kb][s2], o0); o1 = MFMA32(v1, pf[kb][s2], o1); }
        __builtin_amdgcn_wave_barrier();
    }
    l += __shfl_xor(l, 32);
    const float inv = 1.0f / l;
    const bf16_t* gp = proj + (tq + r) * INW + 1536 + h * 64 + 4 * hi;
    bf16_t* yp = y + (tq + r) * DM + h * 64 + 4 * hi;
#pragma unroll
    for (int g = 0; g < 4; ++g) {
        const u32x2 g0 = *(const u32x2*)(gp + 8 * g), g1 = *(const u32x2*)(gp + 32 + 8 * g);
        u32x2 w0, w1;
        w0.x = cvtpk(o0[4 * g] * inv * bf2f((unsigned short)(g0.x & 0xffff)), o0[4 * g + 1] * inv * bf2f((unsigned short)(g0.x >> 16)));
        w0.y = cvtpk(o0[4 * g + 2] * inv * bf2f((unsigned short)(g0.y & 0xffff)), o0[4 * g + 3] * inv * bf2f((unsigned short)(g0.y >> 16)));
        w1.x = cvtpk(o1[4 * g] * inv * bf2f((unsigned short)(g1.x & 0xffff)), o1[4 * g + 1] * inv * bf2f((unsigned short)(g1.x >> 16)));
        w1.y = cvtpk(o1[4 * g + 2] * inv * bf2f((unsigned short)(g1.y & 0xffff)), o1[4 * g + 3] * inv * bf2f((unsigned short)(g1.y >> 16)));
        *(u32x2*)(yp + 8 * g) = w0; *(u32x2*)(yp + 32 + 8 * g) = w1;
    }
}

constexpr int RP = 272;
constexpr int R_QS = 0, R_KS = 64 * RP, R_KD = 2 * 64 * RP, R_VS = 3 * 64 * RP, R_ST = 4 * 64 * RP, R_RED = R_ST + 128 * RP, R_END = R_RED + 4 * 64 * 4;
static_assert(R_END <= 131072, "retention LDS");
__device__ __forceinline__ float log2gamma(int h) { return log2f(1.0f - ex2(-5.0f - (float)h)); }

__device__ __forceinline__ void unpack8(const u32x4 v, float (&f)[8]) {
    f[0] = __uint_as_float(v.x << 16); f[1] = __uint_as_float(v.x & 0xffff0000u); f[2] = __uint_as_float(v.y << 16); f[3] = __uint_as_float(v.y & 0xffff0000u);
    f[4] = __uint_as_float(v.z << 16); f[5] = __uint_as_float(v.z & 0xffff0000u); f[6] = __uint_as_float(v.w << 16); f[7] = __uint_as_float(v.w & 0xffff0000u);
}
__device__ __forceinline__ u32x4 packf8(const float (&f)[8]) { u32x4 w; w.x = cvtpk(f[0], f[1]); w.y = cvtpk(f[2], f[3]); w.z = cvtpk(f[4], f[5]); w.w = cvtpk(f[6], f[7]); return w; }

template <bool WITH_Q>
__device__ __forceinline__ void ret_stage(const bf16_t* __restrict__ proj, const float* __restrict__ rot, LAS unsigned char* lds, int b, int h, int n, float l2g, int tid) {
    const int t = tid >> 3, c0 = (tid & 7) * 8;
    const size_t row = (size_t)b * SEQ + n * 64 + t; const int spos = n * 64 + t;
    const bf16_t* pr = proj + row * INW + h * 128 + c0;
    const u32x4 k1 = *(const u32x4*)(pr + 2560), k2 = *(const u32x4*)(pr + 2560 + 64);
    const u32x4 v1 = *(const u32x4*)(pr + 3072), v2 = *(const u32x4*)(pr + 3072 + 64);
    u32x4 q1, q2; if (WITH_Q) { q1 = *(const u32x4*)(pr + 2048); q2 = *(const u32x4*)(pr + 2048 + 64); }
    const float* cp = rot + (size_t)spos * 64 + c0; const float* sp = rot + (size_t)SEQ * 64 + (size_t)spos * 64 + c0;
    const f32x4 ca = *(const f32x4*)cp, cb = *(const f32x4*)(cp + 4), sa = *(const f32x4*)sp, sb = *(const f32x4*)(sp + 4);
    float cs[8] = {ca[0], ca[1], ca[2], ca[3], cb[0], cb[1], cb[2], cb[3]}, sn[8] = {sa[0], sa[1], sa[2], sa[3], sb[0], sb[1], sb[2], sb[3]};
    float a[8], bb[8], o1[8], o2[8];
    unpack8(k1, a); unpack8(k2, bb);
#pragma unroll
    for (int e = 0; e < 8; ++e) { o1[e] = a[e] * cs[e] - bb[e] * sn[e]; o2[e] = a[e] * sn[e] + bb[e] * cs[e]; }
    LAS unsigned char* rowp = lds + t * RP + c0 * 2;
    if (WITH_Q) { *(LAS u32x4*)(rowp + R_KS) = packf8(o1); *(LAS u32x4*)(rowp + R_KS + 128) = packf8(o2); }
    const float kd = ex2(l2g * (float)(63 - t));
#pragma unroll
    for (int e = 0; e < 8; ++e) { o1[e] *= kd; o2[e] *= kd; }
    *(LAS u32x4*)(rowp + R_KD) = packf8(o1); *(LAS u32x4*)(rowp + R_KD + 128) = packf8(o2);
    *(LAS u32x4*)(rowp + R_VS) = v1; *(LAS u32x4*)(rowp + R_VS + 128) = v2;
    if (WITH_Q) {
        unpack8(q1, a); unpack8(q2, bb);
#pragma unroll
        for (int e = 0; e < 8; ++e) { o1[e] = a[e] * cs[e] - bb[e] * sn[e]; o2[e] = a[e] * sn[e] + bb[e] * cs[e]; }
        *(LAS u32x4*)(rowp + R_QS) = packf8(o1); *(LAS u32x4*)(rowp + R_QS + 128) = packf8(o2);
    }
}
__device__ __forceinline__ void ret_state_update(f32x16 (&accS)[2], LAS const unsigned char* lds, int wid, int lane, float cd) {
    const int hi = lane >> 5, i16 = lane & 15, tq_ = i16 >> 2, tp = i16 & 3, blk = (lane >> 4) & 1;
    const int dvb = wid >> 1, dkb0 = (wid & 1) * 2;
    LAS const unsigned char* nat = lds + (8 * hi + tq_) * RP + (16 * blk + 4 * tp) * 2;
#pragma unroll
    for (int i = 0; i < 16; ++i) { accS[0][i] *= cd; accS[1][i] *= cd; }
#pragma unroll
    for (int s = 0; s < 4; ++s) {
        const bf16x8 va = tr_frag(nat + R_VS + (16 * s) * RP + dvb * 64, 4 * RP);
        const bf16x8 k0 = tr_frag(nat + R_KD + (16 * s) * RP + dkb0 * 64, 4 * RP);
        const bf16x8 k1 = tr_frag(nat + R_KD + (16 * s) * RP + (dkb0 + 1) * 64, 4 * RP);
        accS[0] = MFMA32(va, k0, accS[0]); accS[1] = MFMA32(va, k1, accS[1]);
    }
}
__device__ __forceinline__ void ret_r1_item(const bf16_t* __restrict__ proj, const float* __restrict__ rot, float* __restrict__ Tws, LAS unsigned char* lds, int item, int tid) {
    const int b = item & 7, h = (item >> 3) & 3, seg = item >> 5;
    const int wid = tid >> 6, lane = tid & 63;
    const float l2g = log2gamma(h), cd = ex2(l2g * 64.0f);
    f32x16 accS[2];
#pragma unroll
    for (int i = 0; i < 16; ++i) { accS[0][i] = 0.f; accS[1][i] = 0.f; }
    for (int c = 0; c < 8; ++c) {
        ret_stage<false>(proj, rot, lds, b, h, seg * 8 + c, l2g, tid);
        __syncthreads();
        ret_state_update(accS, lds, wid, lane, cd);
        __syncthreads();
    }
    float* tp = Tws + (size_t)item * 16384 + (size_t)wid * 2048 + lane;
#pragma unroll
    for (int kk = 0; kk < 2; ++kk)
#pragma unroll
        for (int i = 0; i < 16; ++i) tp[(kk * 16 + i) * 64] = accS[kk][i];
}
__device__ __forceinline__ void ret_r2_item(const bf16_t* __restrict__ proj, const float* __restrict__ rot, const float* __restrict__ Tws, bf16_t* __restrict__ y, LAS unsigned char* lds, int item, int tid) {
    const int b = item & 7, h = (item >> 3) & 3, seg = item >> 5;
    const int wid = tid >> 6, lane = tid & 63, r = lane & 31, hi = lane >> 5;
    const int dvb = wid >> 1, ib = wid & 1, dkb0 = (wid & 1) * 2;
    const float l2g = log2gamma(h), cd = ex2(l2g * 64.0f), cd8 = ex2(l2g * 512.0f);
    f32x16 accS[2];
#pragma unroll
    for (int i = 0; i < 16; ++i) { accS[0][i] = 0.f; accS[1][i] = 0.f; }
    for (int sp = 0; sp < seg; ++sp) {
        const float* tp = Tws + (size_t)(b + 8 * h + 32 * sp) * 16384 + (size_t)wid * 2048 + lane;
#pragma unroll
        for (int kk = 0; kk < 2; ++kk)
#pragma unroll
            for (int i = 0; i < 16; ++i) accS[kk][i] = accS[kk][i] * cd8 + tp[(kk * 16 + i) * 64];
    }
    const int i16 = lane & 15, tq_ = i16 >> 2, tp_ = i16 & 3, blk = (lane >> 4) & 1;
    LAS const unsigned char* vperm = lds + R_VS + (4 * hi + tq_) * RP + (dvb * 32 + 16 * blk + 4 * tp_) * 2;
    LAS float* red = (LAS float*)(lds + R_RED);
    const int itok = ib * 32 + r;
    const float qdec = ex2(l2g * (float)(itok + 1));
    for (int c = 0; c < 8; ++c) {
        const int n = seg * 8 + c;
#pragma unroll
        for (int kk = 0; kk < 2; ++kk)
#pragma unroll
            for (int i = 0; i < 16; ++i) *(LAS unsigned short*)(lds + R_ST + (dvb * 32 + crow(i, hi)) * RP + ((dkb0 + kk) * 32 + r) * 2) = (unsigned short)(cvtpk(accS[kk][i], 0.f) & 0xffffu);
        ret_stage<true>(proj, rot, lds, b, h, n, l2g, tid);
        __syncthreads();
        bf16x8 qf[8];
        { LAS const unsigned char* qp = lds + R_QS + itok * RP + 16 * hi;
#pragma unroll
          for (int s = 0; s < 8; ++s) qf[s] = *(LAS const bf16x8*)(qp + 32 * s); }
        f32x16 a0, a1, o;
#pragma unroll
        for (int i = 0; i < 16; ++i) { a0[i] = 0.f; a1[i] = 0.f; o[i] = 0.f; }
        { LAS const unsigned char* kp = lds + R_KS + r * RP + 16 * hi;
#pragma unroll
          for (int s = 0; s < 8; ++s) { const bf16x8 k0 = *(LAS const bf16x8*)(kp + 32 * s), k1 = *(LAS const bf16x8*)(kp + 32 * RP + 32 * s);
              a0 = MFMA32(k0, qf[s], a0); a1 = MFMA32(k1, qf[s], a1); } }
#pragma unroll
        for (int reg = 0; reg < 16; ++reg) { const int j0 = crow(reg, hi); const int d0 = itok - j0, d1 = itok - j0 - 32;
            a0[reg] *= ex2(l2g * (float)(d0 < 0 ? -d0 : d0)); a1[reg] *= ex2(l2g * (float)(d1 < 0 ? -d1 : d1)); }
        { LAS const unsigned char* sp = lds + R_ST + (dvb * 32 + r) * RP + 16 * hi;
#pragma unroll
          for (int s = 0; s < 8; ++s) { const bf16x8 sf = *(LAS const bf16x8*)(sp + 32 * s); o = MFMA32(sf, qf[s], o); } }
#pragma unroll
        for (int i = 0; i < 16; ++i) o[i] *= qdec;
        { const bf16x8 p00 = pack8(a0, 0), p01 = pack8(a0, 1), p10 = pack8(a1, 0), p11 = pack8(a1, 1);
          o = MFMA32(tr_frag(vperm + 0 * RP, 8 * RP), p00, o);
          o = MFMA32(tr_frag(vperm + 16 * RP, 8 * RP), p01, o);
          o = MFMA32(tr_frag(vperm + 32 * RP, 8 * RP), p10, o);
          o = MFMA32(tr_frag(vperm + 48 * RP, 8 * RP), p11, o); }
        float ss = 0.f;
#pragma unroll
        for (int i = 0; i < 16; ++i) ss += o[i] * o[i];
        ss += __shfl_xor(ss, 32);
        if (hi == 0) red[dvb * 64 + itok] = ss;
        __syncthreads();
        const float tot = (red[itok] + red[64 + itok]) + (red[128 + itok] + red[192 + itok]);
        const float rstd = 1.0f / sqrtf(tot * (1.0f / RD) + EPS);
        { const size_t row = (size_t)b * SEQ + n * 64 + itok;
          const bf16_t* gp = proj + row * INW + 3584 + h * 128 + dvb * 32 + 4 * hi;
          bf16_t* yp = y + row * DM + 512 + h * 128 + dvb * 32 + 4 * hi;
#pragma unroll
          for (int g = 0; g < 4; ++g) { const u32x2 gv = *(const u32x2*)(gp + 8 * g); u32x2 w;
              w.x = cvtpk(o[4 * g] * rstd * bf2f((unsigned short)(gv.x & 0xffff)), o[4 * g + 1] * rstd * bf2f((unsigned short)(gv.x >> 16)));
              w.y = cvtpk(o[4 * g + 2] * rstd * bf2f((unsigned short)(gv.y & 0xffff)), o[4 * g + 3] * rstd * bf2f((unsigned short)(gv.y >> 16)));
              *(u32x2*)(yp + 8 * g) = w; } }
        ret_state_update(accS, lds, wid, lane, cd);
        __syncthreads();
    }
}

constexpr int N_PHASES = 11;
__global__ void __launch_bounds__(NTHREADS, 2) mega(Args a) {
    extern __shared__ __attribute__((aligned(16))) unsigned char lds_raw[];
    LAS unsigned char* lds = (LAS unsigned char*)lds_raw;
    cg::grid_group grid = cg::this_grid();
    const int G = gridDim.x, bx = blockIdx.x;
#define PHASE_IDS int tid = threadIdx.x; asm volatile("" : "+v"(tid)); const int lane = tid & 63, wid = __builtin_amdgcn_readfirstlane(tid >> 6); const int gw = bx * NWAVES + wid, NGW = G * NWAVES; (void)lane; (void)gw; (void)NGW;
    unsigned char* ws = a.ws;
    bf16_t* Win_t = (bf16_t*)(ws + WS_WIN); bf16_t* Wout_t = (bf16_t*)(ws + WS_WOUT);
    float* rot = (float*)(ws + WS_ROT); float* Tws = (float*)(ws + WS_T);
    bf16_t* hb = (bf16_t*)(ws + WS_HB); bf16_t* proj = (bf16_t*)(ws + WS_PROJ);
    const int lo = a.ph_lo, hi_ = a.ph_hi;
#ifdef ONLY_PH
#define IN(k) ((((k) == 0 ? 0 : ((k) - 1) % 5 + 1) == ONLY_PH) && lo <= (k) && (k) < hi_)
#else
#define IN(k) (lo <= (k) && (k) < hi_)
#endif
#define SEAM(k) do { if (IN(k) && IN((k) + 1)) grid.sync(); } while (0)

    if (IN(0)) {
        PHASE_IDS
        LAS float* scr = (LAS float*)(lds + wid * 16384);
        constexpr int I_IN = (DM / 64) * (INW / 32), I_OUT = (DM / 64) * (DM / 32), I_L = I_IN + I_OUT;
        for (int it = gw; it < DEPTH * I_L; it += NGW) {
            const int l = it / I_L, r = it % I_L;
            if (r < I_IN) transpose_item(a.win + (size_t)l * DM * INW, DM, INW, Win_t + (size_t)l * INW * DM, scr, r, lane);
            else transpose_item(a.wout + (size_t)l * DM * DM, DM, DM, Wout_t + (size_t)l * DM * DM, scr, r - I_IN, lane);
        }
        for (int idx = bx * NTHREADS + tid; idx < SEQ * 64; idx += G * NTHREADS) { float c, s; rot_entry(a.pos[idx >> 6], idx & 63, c, s); rot[idx] = c; rot[SEQ * 64 + idx] = s; }
        for (int m = gw; m < MTOK; m += NGW) rms_row_bf16(a.x + (size_t)m * DM, a.ng, hb + (size_t)m * DM, lane);
    }
    SEAM(0);
#pragma unroll
    for (int l = 0; l < DEPTH; ++l) {
        const int p0 = 5 * l;
        if (IN(p0 + 1)) {
            pg8::Gemm g{hb, Win_t + (size_t)l * INW * DM, MTOK, INW, DM}; pg8::StaticOrder S; S.init(MTOK, INW, G, bx);
            EpiProj E{proj};
            pg8::gemm_phase<EpiProj, pg8::StaticOrder, PG8_ALIGN, PG8_SP2>(lds, g, S, E);
        }
        SEAM(p0 + 1);
        if (IN(p0 + 2)) {
            PHASE_IDS
            for (int item = bx; item < 256; item += G) ret_r1_item(proj, rot, Tws, lds, item, tid);
            const float* relb = a.relb + (size_t)l * AH * NREL;
            LAS unsigned char* wl = lds + wid * ATT_WAVE_LDS;
            for (int u = bx; u < 1024; u += G) {
                const int b = u & 7, k = u >> 3, n = k >> 1, hg = k & 1;
                attn_unit(proj, hb, relb, wl, b, n, hg * 4 + (wid >> 1), wid & 1, lane);
            }
        }
        SEAM(p0 + 2);
        if (IN(p0 + 3)) {
            PHASE_IDS
            for (int item = bx; item < 256; item += G) ret_r2_item(proj, rot, Tws, hb, lds, item, tid);
        }
        SEAM(p0 + 3);
        if (IN(p0 + 4)) {
            pg8::Gemm g{hb, Wout_t + (size_t)l * DM * DM, MTOK, DM, DM}; pg8::StaticOrder S; S.init(MTOK, DM, G, bx);
            EpiRes E{l == 0 ? a.x : (const float*)a.out, a.out};
            pg8::gemm_phase<EpiRes, pg8::StaticOrder, PG8_ALIGN, PG8_SP2>(lds, g, S, E);
        }
        SEAM(p0 + 4);
        if (IN(p0 + 5)) {
            PHASE_IDS
            if (l + 1 < DEPTH) { for (int m = gw; m < MTOK; m += NGW) rms_row_bf16(a.out + (size_t)m * DM, a.ng + (size_t)(l + 1) * DM, hb + (size_t)m * DM, lane); }
            else { for (int m = gw; m < MTOK; m += NGW) rms_row_f32(a.out + (size_t)m * DM, a.fg, a.out + (size_t)m * DM, lane); }
        }
        if (l + 1 < DEPTH) SEAM(p0 + 5);
    }
#undef IN
#undef SEAM
}

extern "C" void kernel_launch(void* const* d_in, const int* in_sizes, int n_in, void* d_out, int out_size, void* d_ws, size_t ws_size, hipStream_t stream) {
    static int grid = 0;
    if (grid == 0) {
        int dev = 0, cus = 0, per_cu = 0;
        hipGetDevice(&dev);
        hipDeviceGetAttribute(&cus, hipDeviceAttributeMultiprocessorCount, dev);
        if (hipFuncSetAttribute((const void*)mega, hipFuncAttributeMaxDynamicSharedMemorySize, LDS_BYTES) != hipSuccess) fprintf(stderr, "kernel_launch: hipFuncSetAttribute failed\n");
        if (hipOccupancyMaxActiveBlocksPerMultiprocessor(&per_cu, (const void*)mega, NTHREADS, LDS_BYTES) != hipSuccess || per_cu < 1) { fprintf(stderr, "kernel_launch: occupancy query says %d\n", per_cu); per_cu = 1; }
        (void)hipGetLastError();
        grid = cus * per_cu;
        if (ws_size < WS_END) fprintf(stderr, "kernel_launch: workspace too small: %zu < %zu\n", ws_size, (size_t)WS_END);
    }
    Args a{};
    a.x = (const float*)d_in[0]; a.pos = (const int*)d_in[1]; a.ng = (const float*)d_in[2]; a.win = (const float*)d_in[3]; a.wout = (const float*)d_in[4];
    a.relb = (const float*)d_in[5]; a.fg = (const float*)d_in[6]; a.out = (float*)d_out; a.ws = (unsigned char*)d_ws;
#if MK_MULTI
    for (int ph = 0; ph < N_PHASES; ++ph) { a.ph_lo = ph; a.ph_hi = ph + 1; hipLaunchKernelGGL(mega, dim3(grid), dim3(NTHREADS), LDS_BYTES, stream, a); }
#else
    a.ph_lo = 0; a.ph_hi = N_PHASES;
    void* args[] = {&a};
    hipError_t e = hipLaunchCooperativeKernel((void*)mega, dim3(grid), dim3(NTHREADS), args, LDS_BYTES, stream);
    if (e != hipSuccess) fprintf(stderr, "cooperative launch failed: %s (grid %d)\n", hipGetErrorString(e), grid);
#endif
}
```

```cpp
#include <hip/hip_runtime.h>
#include <hip/hip_cooperative_groups.h>
#include <cstdio>
#include <cstdint>
namespace cg = cooperative_groups;
namespace pg8 {
#define PG8_LAS __attribute__((address_space(3)))
typedef unsigned short bf16_t;
typedef short bf16x8 __attribute__((ext_vector_type(8)));
typedef float f32x4 __attribute__((ext_vector_type(4)));
typedef unsigned u32x4 __attribute__((ext_vector_type(4)));
constexpr int BM = 256, BK = 64, HALF = 128, HTB = HALF * BK * 2  , STAGE_BYTES = 8 * HTB, NXCD = 8, WGM = 8;

__host__ __device__ __forceinline__ int lds_byte(int r, int c) { const int st = (r >> 4) * 2 + (c >> 5), rr = r & 15, cc = c & 31, ob = rr * 64 + cc * 2; return st * 1024 + (ob ^ (((ob >> 9) & 1) << 5)); }
__host__ __device__ __forceinline__ void stage_rc(int b, int& R, int& C) { const int st = b / 1024, sb = b % 1024, swz = sb ^ (((sb >> 9) & 1) << 5); R = (st >> 1) * 16 + swz / 64; C = (st & 1) * 32 + (swz % 64) / 2; }
__host__ __device__ __forceinline__ int perm32(int rho) { const int n = rho >> 4, i = rho & 15; return 8 * (i >> 2) + 4 * n + (i & 3); }

struct Unit { int pm, pn; };
struct Gemm { const bf16_t* A; const bf16_t* Bt; int M, N, K; };

struct StaticOrder {
    int nM, nN, nwg, G, c;
    __host__ __device__ void init(int M, int N, int G_, int c_) { nM = M / BM; nN = N / BM; nwg = nM * nN; G = G_; c = c_; }
    __host__ __device__ bool next(int i, Unit& u) const {
        const long L = (long)i * G + c; if (L >= nwg) return false;
        int wgid = (int)L; { const int q = nwg / NXCD, r = nwg % NXCD, xcd = wgid % NXCD, off = wgid / NXCD; wgid = (xcd < r ? xcd * (q + 1) : r * (q + 1) + (xcd - r) * q) + off; }
        const int nig = WGM * nN, gid = wgid / nig, fm = gid * WGM, gsz = (nM - fm) < WGM ? (nM - fm) : WGM;
        u.pm = fm + ((wgid % nig) % gsz); u.pn = (wgid % nig) / gsz; return true;
    }
    __device__ __forceinline__ void a_ready(const Unit&) const {}
    __device__ __forceinline__ void done(const Unit&) const {}
};

__device__ __forceinline__ unsigned cvt_pk_bf16(float lo, float hi) { unsigned r; asm volatile("v_cvt_pk_bf16_f32 %0, %1, %2" : "=v"(r) : "v"(lo), "v"(hi)); return r; }
typedef float f32x2 __attribute__((ext_vector_type(2)));
__device__ __forceinline__ f32x2 gelu_pk(f32x2 v) {
    const f32x2 av = __builtin_elementwise_abs(v), d = av * 0.2316418882f + 1.0f;
    f32x2 t; t.x = __builtin_amdgcn_rcpf(d.x); t.y = __builtin_amdgcn_rcpf(d.y);
    f32x2 q = t * 0.5307027145f + (-0.7265760135f); q = q * t + 0.7107068705f; q = q * t + (-0.142248368f); q = q * t + 0.127414796f; q = q * t;
    const f32x2 s = (v * v) * (-0.72134752044f);
    f32x2 e; e.x = __builtin_amdgcn_exp2f(s.x); e.y = __builtin_amdgcn_exp2f(s.y);
    const f32x2 m = v * (q * e), r = v - m;
    f32x2 o; o.x = v.x < 0.f ? m.x : r.x; o.y = v.y < 0.f ? m.y : r.y; return o;
}

template <int ACT  > struct EpiBf16 {
    static constexpr bool PERM = true, AFTER_DRAIN = false; static_assert(ACT == 0 || ACT == 1, "EpiBf16: ACT is 0 (none) or 1 (gelu_pk)");
    bf16_t* O; int ldc; const float* bias; int split_cols; size_t split_stride; float scale0;
    __device__ __forceinline__ void operator()(const f32x4 (&acc)[2][2][4][2], const Unit& u, int wr, int wc, int fr, int fq) const {
        const int row0 = u.pm * BM + wr * 64 + fr; int colt = u.pn * BM; bf16_t* base = O;
        float sc = 1.f; if (split_cols) { const int t = colt / split_cols; base += (size_t)t * split_stride; colt -= t * split_cols; if (t == 0) sc = scale0; }
        const int col0 = colt + wc * 32 + 8 * fq, bcol0 = u.pn * BM + wc * 32 + 8 * fq;
        f32x4 bv[2][2];
#pragma unroll
        for (int bj = 0; bj < 2; ++bj)
#pragma unroll
            for (int n = 0; n < 2; ++n) bv[bj][n] = bias ? *(const f32x4*)(bias + bcol0 + bj * HALF + 4 * n) : (f32x4){0.f, 0.f, 0.f, 0.f};
#pragma unroll
        for (int ai = 0; ai < 2; ++ai)
#pragma unroll
            for (int m = 0; m < 4; ++m) { bf16_t* rowp = base + (size_t)(row0 + ai * HALF + m * 16) * ldc + col0;
#pragma unroll
                for (int bj = 0; bj < 2; ++bj) { f32x4 v0 = acc[ai][bj][m][0] + bv[bj][0], v1 = acc[ai][bj][m][1] + bv[bj][1];
                    if (ACT == 1) { f32x2 a = gelu_pk((f32x2){v0[0], v0[1]}), b = gelu_pk((f32x2){v0[2], v0[3]}), c = gelu_pk((f32x2){v1[0], v1[1]}), d = gelu_pk((f32x2){v1[2], v1[3]});
                        v0 = (f32x4){a.x, a.y, b.x, b.y}; v1 = (f32x4){c.x, c.y, d.x, d.y}; }
                    v0 = v0 * sc; v1 = v1 * sc; u32x4 w; w.x = cvt_pk_bf16(v0[0], v0[1]); w.y = cvt_pk_bf16(v0[2], v0[3]); w.z = cvt_pk_bf16(v1[0], v1[1]); w.w = cvt_pk_bf16(v1[2], v1[3]);
                    *(u32x4*)(rowp + bj * HALF) = w; } }
    }
};

struct PanelStats {
    unsigned* xbuf;
    unsigned* cnt;
    unsigned* tmo;
    int ntn; float eps;
    unsigned code;
    __device__ __forceinline__ bool run(const f32x4 (&v)[2][2][4][2], const Unit& u, int wr, int wc, int fr, int fq, PG8_LAS unsigned char* lds, int wid, int lane) const {
        typedef float f32x2v __attribute__((ext_vector_type(2)));
        PG8_LAS f32x2v* P = (PG8_LAS f32x2v*)lds;
        PG8_LAS f32x2v* S = (PG8_LAS f32x2v*)(lds + 8192);
        PG8_LAS unsigned* flag = (PG8_LAS unsigned*)(lds + 8192 + 2048);
#pragma unroll
        for (int ai = 0; ai < 2; ++ai)
#pragma unroll
            for (int m = 0; m < 4; ++m) {
                float s = 0.f;
#pragma unroll
                for (int bj = 0; bj < 2; ++bj)
#pragma unroll
                    for (int n = 0; n < 2; ++n) { const f32x4 x = v[ai][bj][m][n]; s += (x[0] + x[1]) + (x[2] + x[3]); }
                s += __shfl_xor(s, 16); s += __shfl_xor(s, 32);
                const float mw = s * (1.0f / 64.0f); float q = 0.f;
#pragma unroll
                for (int bj = 0; bj < 2; ++bj)
#pragma unroll
                    for (int n = 0; n < 2; ++n) { const f32x4 d = v[ai][bj][m][n] - mw; q += (d[0] * d[0] + d[1] * d[1]) + (d[2] * d[2] + d[3] * d[3]); }
                q += __shfl_xor(q, 16); q += __shfl_xor(q, 32);
                if (fq == 0) P[(ai * HALF + wr * 64 + m * 16 + fr) * 4 + wc] = (f32x2v){mw, q};
            }
        asm volatile("s_waitcnt lgkmcnt(0)" ::: "memory"); __builtin_amdgcn_s_barrier(); asm volatile("" ::: "memory");
#if defined(BROKEN_EXCHANGE_NO_WAIT)
#warning BROKEN CONTROL BUILD: the row-statistics exchange does not wait; results are wrong by design
        if (blockIdx.x >= 64) { const long long t0_ = clock64(); while (clock64() - t0_ < 60000) __builtin_amdgcn_s_sleep(8); }
#endif
        const int row = wid * 32 + (lane & 31);
        if (lane < 32) {
            const f32x2v a = P[row * 4 + 0], b = P[row * 4 + 1], c = P[row * 4 + 2], d = P[row * 4 + 3];
            const float mt = (a.x + b.x + c.x + d.x) * 0.25f;
            const float da = a.x - mt, db = b.x - mt, dc = c.x - mt, dd = d.x - mt;
            const float m2 = (a.y + b.y) + (c.y + d.y) + 64.0f * ((da * da + db * db) + (dc * dc + dd * dd));
            unsigned long long* slot = (unsigned long long*)xbuf + ((size_t)(u.pm * BM + row) * 4 + u.pn);
            __hip_atomic_store(slot, ((unsigned long long)__float_as_uint(m2) << 32) | __float_as_uint(mt), __ATOMIC_RELAXED, __HIP_MEMORY_SCOPE_AGENT);
        }
        asm volatile("s_waitcnt vmcnt(0)" ::: "memory");
        if (lane == 0) __hip_atomic_fetch_add(cnt + 64 * u.pm, 1u, __ATOMIC_RELAXED, __HIP_MEMORY_SCOPE_AGENT);
        if (wid == 0) {
            bool dead = false; const unsigned long long t0 = __builtin_amdgcn_s_memrealtime(); const unsigned want = 8u * (unsigned)ntn;
            for (;;) {
#if defined(BROKEN_EXCHANGE_NO_WAIT)
                break;
#endif
                if ((unsigned)__builtin_amdgcn_readfirstlane(__hip_atomic_load(cnt + 64 * u.pm, __ATOMIC_RELAXED, __HIP_MEMORY_SCOPE_AGENT)) >= want) break;
                if (__builtin_amdgcn_s_memrealtime() - t0 > 2000000ull) {
                    if (lane == 0) { unsigned expect = 0u; __hip_atomic_compare_exchange_strong(tmo + 1, &expect, code | (unsigned)(u.pm & 0xff), __ATOMIC_RELAXED, __ATOMIC_RELAXED, __HIP_MEMORY_SCOPE_AGENT);
                                     __hip_atomic_store(tmo, 1u, __ATOMIC_RELAXED, __HIP_MEMORY_SCOPE_AGENT); }
                    dead = true; break; }
                __builtin_amdgcn_s_sleep(2);
            }
            __builtin_amdgcn_fence(__ATOMIC_ACQUIRE, "agent");
            if (lane == 0) flag[0] = dead ? 1u : 0u;
        }
        asm volatile("s_waitcnt vmcnt(0) lgkmcnt(0)" ::: "memory"); __builtin_amdgcn_s_barrier(); asm volatile("" ::: "memory");
        const bool bad = flag[0] != 0u;
        if (lane < 32) {
            const unsigned long long* slot = (const unsigned long long*)xbuf + (size_t)(u.pm * BM + row) * 4; float mt[4], m2[4]; float ms = 0.f;
#pragma unroll
            for (int t = 0; t < 4; ++t) { if (t < ntn) { const unsigned long long w = __hip_atomic_load(slot + t, __ATOMIC_RELAXED, __HIP_MEMORY_SCOPE_AGENT); mt[t] = __uint_as_float((unsigned)w); m2[t] = __uint_as_float((unsigned)(w >> 32)); } else { mt[t] = 0.f; m2[t] = 0.f; } ms += mt[t]; }
            const float mean = ms / (float)ntn; float q = 0.f;
#pragma unroll
            for (int t = 0; t < 4; ++t) if (t < ntn) { const float dm = mt[t] - mean; q += m2[t] + 256.0f * dm * dm; }
            S[row] = (f32x2v){mean, 1.0f / sqrtf(q / (256.0f * (float)ntn) + eps)};
        }
        asm volatile("s_waitcnt lgkmcnt(0)" ::: "memory"); __builtin_amdgcn_s_barrier(); asm volatile("" ::: "memory");
        return bad;
    }
};
struct EpiLnRes {
    static constexpr bool PERM = false, AFTER_DRAIN = true;
    const float* base; float* out; int ldc; const float* bias; PanelStats st; unsigned poison;
    __device__ __forceinline__ void fused(f32x4 (&acc)[2][2][4][2], const Unit& u, int wr, int wc, int fr, int fq, PG8_LAS unsigned char* lds, int wid, int lane) const {
        typedef float f32x2v __attribute__((ext_vector_type(2)));
        const PG8_LAS f32x2v* S = (const PG8_LAS f32x2v*)(lds + 8192);
        const int col0 = u.pn * BM + wc * 32 + 4 * fq;
#pragma unroll
        for (int bj = 0; bj < 2; ++bj)
#pragma unroll
            for (int n = 0; n < 2; ++n) { const f32x4 bv = bias ? *(const f32x4*)(bias + col0 + bj * HALF + n * 16) : (f32x4){0.f, 0.f, 0.f, 0.f};
#pragma unroll
                for (int ai = 0; ai < 2; ++ai)
#pragma unroll
                    for (int m = 0; m < 4; ++m) acc[ai][bj][m][n] += bv; }
        f32x4 pre[4][2][2];
#pragma unroll
        for (int m = 0; m < 4; ++m) { const size_t off = (size_t)(u.pm * BM + wr * 64 + m * 16 + fr) * ldc + col0;
#pragma unroll
            for (int bj = 0; bj < 2; ++bj)
#pragma unroll
                for (int n = 0; n < 2; ++n) pre[m][bj][n] = *(const f32x4*)(base + off + bj * HALF + n * 16); }
        const bool bad = st.run(acc, u, wr, wc, fr, fq, lds, wid, lane) || poison != 0u;
        const float qnan = __builtin_nanf("");
#pragma unroll
        for (int ai = 0; ai < 2; ++ai)
#pragma unroll
            for (int m = 0; m < 4; ++m) { const int r = ai * HALF + wr * 64 + m * 16 + fr; const f32x2v sr = S[r]; const size_t off = (size_t)(u.pm * BM + r) * ldc + col0;
#pragma unroll
                for (int bj = 0; bj < 2; ++bj)
#pragma unroll
                    for (int n = 0; n < 2; ++n) { const f32x4 bs = ai == 0 ? pre[m][bj][n] : *(const f32x4*)(base + off + bj * HALF + n * 16); f32x4 o = bs + (acc[ai][bj][m][n] - sr.x) * sr.y;
                        if (bad) o = (f32x4){qnan, qnan, qnan, qnan}; *(f32x4*)(out + off + bj * HALF + n * 16) = o; }
                if (m & 1) asm volatile("" ::: "memory"); }
    }
};
struct EpiLnResLn {
    static constexpr bool PERM = false, AFTER_DRAIN = true;
    const float* base; float* out; bf16_t* xn; int ldc; const float* bias; PanelStats st1, st2; unsigned poison;
    __device__ __forceinline__ void fused(f32x4 (&acc)[2][2][4][2], const Unit& u, int wr, int wc, int fr, int fq, PG8_LAS unsigned char* lds, int wid, int lane) const {
        typedef float f32x2v __attribute__((ext_vector_type(2))); typedef unsigned u32x2v __attribute__((ext_vector_type(2)));
        const PG8_LAS f32x2v* S = (const PG8_LAS f32x2v*)(lds + 8192);
        const int col0 = u.pn * BM + wc * 32 + 4 * fq;
#pragma unroll
        for (int bj = 0; bj < 2; ++bj)
#pragma unroll
            for (int n = 0; n < 2; ++n) { const f32x4 bv = bias ? *(const f32x4*)(bias + col0 + bj * HALF + n * 16) : (f32x4){0.f, 0.f, 0.f, 0.f};
#pragma unroll
                for (int ai = 0; ai < 2; ++ai)
#pragma unroll
                    for (int m = 0; m < 4; ++m) acc[ai][bj][m][n] += bv; }
        bool bad = st1.run(acc, u, wr, wc, fr, fq, lds, wid, lane) || poison != 0u;
        const float qnan = __builtin_nanf("");
#pragma unroll
        for (int ai = 0; ai < 2; ++ai)
#pragma unroll
            for (int m = 0; m < 4; ++m) { const int r = ai * HALF + wr * 64 + m * 16 + fr; const f32x2v sr = S[r]; const size_t off = (size_t)(u.pm * BM + r) * ldc + col0;
#pragma unroll
                for (int bj = 0; bj < 2; ++bj)
#pragma unroll
                    for (int n = 0; n < 2; ++n) { const f32x4 bs = *(const f32x4*)(base + off + bj * HALF + n * 16); acc[ai][bj][m][n] = bs + (acc[ai][bj][m][n] - sr.x) * sr.y; }
                asm volatile("" : "+v"(acc[ai][0][m][0]), "+v"(acc[ai][0][m][1]), "+v"(acc[ai][1][m][0]), "+v"(acc[ai][1][m][1]));
                if (m & 1) asm volatile("" ::: "memory"); }
        const bool bad1 = bad;
        bad = st2.run(acc, u, wr, wc, fr, fq, lds, wid, lane) || bad;
#pragma unroll
        for (int ai = 0; ai < 2; ++ai)
#pragma unroll
            for (int m = 0; m < 4; ++m) { const int r = ai * HALF + wr * 64 + m * 16 + fr; const f32x2v sr = S[r]; const size_t off = (size_t)(u.pm * BM + r) * ldc + col0;
#pragma unroll
                for (int bj = 0; bj < 2; ++bj)
#pragma unroll
                    for (int n = 0; n < 2; ++n) { const f32x4 x1 = acc[ai][bj][m][n]; *(f32x4*)(out + off + bj * HALF + n * 16) = bad1 ? (f32x4){qnan, qnan, qnan, qnan} : x1;
                        const f32x4 o = (x1 - sr.x) * sr.y; u32x2v w; w.x = cvt_pk_bf16(o[0], o[1]); w.y = cvt_pk_bf16(o[2], o[3]);
                        if (bad) { w.x = 0x7fc07fc0u; w.y = 0x7fc07fc0u; } *(u32x2v*)(xn + off + bj * HALF + n * 16) = w; }
                asm volatile("" ::: "memory"); }
    }
};

template <class Epi, class Sched, bool ALIGN_EPI = false, bool SP2 = false>
__device__ __forceinline__ void gemm_phase(PG8_LAS unsigned char* lds, const Gemm g, const Sched& S, const Epi& E) {
    int tid_o = threadIdx.x; asm volatile("" : "+v"(tid_o));
    const int tid = tid_o, wid = __builtin_amdgcn_readfirstlane(tid >> 6), lane = tid & 63, wr = wid >> 2, wc = wid & 3, fr = lane & 15, fq = lane >> 4;
    const int K = g.K, nt = K / BK;
    unsigned voffA[2], voffB[2];
#pragma unroll
    for (int i = 0; i < 2; ++i) { int R, C; stage_rc(tid * 16 + i * 8192, R, C); const int Rb = Epi::PERM ? ((R & ~31) + perm32(R & 31)) : R;
        voffA[i] = (unsigned)(R * K + C) * 2u; voffB[i] = (unsigned)(Rb * K + C) * 2u; }
    const size_t kstep = (size_t)(BK * 2);
    const size_t hstep = (size_t)HALF * K * 2;
    const size_t tstep = 2 * hstep;
    const unsigned ldsw = (unsigned)wid * 1024u;
    const int aoff = lds_byte(wr * 64 + fr, fq * 8), boff = lds_byte(wc * 32 + fr, fq * 8);
#define PG8_SA(b, h) (((b) * 2 + (h)) * HTB)
#define PG8_SB(b, h) ((4 + (b) * 2 + (h)) * HTB)
#define PG8_STAGE(bufoff, gbase, voff) do { _Pragma("unroll") for (int _i = 0; _i < 2; ++_i) \
        __builtin_amdgcn_global_load_lds((const unsigned*)((const char*)(gbase) + (voff)[_i]), (PG8_LAS unsigned*)(lds + (bufoff) + ldsw + _i * 8192), 16, 0, 0); } while (0)
#define PG8_LDA(dst, b, h) do { _Pragma("unroll") for (int m = 0; m < 4; ++m) _Pragma("unroll") for (int k = 0; k < 2; ++k) dst[m][k] = *(const PG8_LAS bf16x8*)(lds + PG8_SA(b, h) + aoff + m * 2048 + k * 1024); } while (0)
#define PG8_LDB(dst, b, h) do { _Pragma("unroll") for (int n = 0; n < 2; ++n) _Pragma("unroll") for (int k = 0; k < 2; ++k) dst[n][k] = *(const PG8_LAS bf16x8*)(lds + PG8_SB(b, h) + boff + n * 2048 + k * 1024); } while (0)
#define PG8_MMA(ai, bj, At, Bt) do { __builtin_amdgcn_s_setprio(1); _Pragma("unroll") for (int m = 0; m < 4; ++m) _Pragma("unroll") for (int n = 0; n < 2; ++n) _Pragma("unroll") for (int k = 0; k < 2; ++k) \
        acc[ai][bj][m][n] = __builtin_amdgcn_mfma_f32_16x16x32_bf16(Bt[n][k], At[m][k], acc[ai][bj][m][n], 0, 0, 0); __builtin_amdgcn_s_setprio(0); } while (0)
#define PG8_WAIT_V(n) asm volatile("s_waitcnt vmcnt(" #n ")" ::: "memory")
#define PG8_WAIT_L(n) asm volatile("s_waitcnt lgkmcnt(" #n ")" ::: "memory")
#define PG8_BAR __builtin_amdgcn_s_barrier()
#define PG8_SCHED __builtin_amdgcn_sched_barrier(0)
    Unit cur, nxt; int ui = 0;
    if (!S.next(0, cur)) return;
    f32x4 acc[2][2][4][2];
#pragma unroll
    for (int a = 0; a < 2; ++a)
#pragma unroll
        for (int b = 0; b < 2; ++b)
#pragma unroll
            for (int m = 0; m < 4; ++m)
#pragma unroll
                for (int n = 0; n < 2; ++n) acc[a][b][m][n] = (f32x4){0.f, 0.f, 0.f, 0.f};
    bf16x8 At[4][2], B0[2][2], B1[2][2];
    const char* cA = (const char*)g.A + (size_t)cur.pm * tstep; const char* cB = (const char*)g.Bt + (size_t)cur.pn * tstep;
    S.a_ready(cur);
    if constexpr (SP2) {
        PG8_STAGE(PG8_SB(0, 0), cB, voffB); PG8_STAGE(PG8_SB(0, 1), cB + hstep, voffB); PG8_STAGE(PG8_SA(0, 0), cA, voffA); PG8_STAGE(PG8_SA(0, 1), cA + hstep, voffA);
        if (wr == 1) PG8_BAR;
        PG8_WAIT_V(2); PG8_BAR;
        PG8_STAGE(PG8_SB(1, 0), cB + kstep, voffB); PG8_STAGE(PG8_SA(1, 0), cA + kstep, voffA); PG8_STAGE(PG8_SB(1, 1), cB + hstep + kstep, voffB);
        PG8_WAIT_V(6); PG8_BAR;
    } else {
        PG8_STAGE(PG8_SB(0, 0), cB, voffB); PG8_STAGE(PG8_SA(0, 0), cA, voffA); PG8_STAGE(PG8_SB(0, 1), cB + hstep, voffB); PG8_STAGE(PG8_SA(0, 1), cA + hstep, voffA);
        if (wr == 1) PG8_BAR;
        PG8_WAIT_V(4); PG8_BAR;
        PG8_STAGE(PG8_SB(1, 0), cB + kstep, voffB); PG8_STAGE(PG8_SA(1, 0), cA + kstep, voffA); PG8_STAGE(PG8_SB(1, 1), cB + hstep + kstep, voffB);
        PG8_WAIT_V(6); PG8_BAR;
    }
    for (;;) {
        const bool has_next = S.next(ui + 1, nxt);
        const char* nA = has_next ? (const char*)g.A + (size_t)nxt.pm * tstep : cA; const char* nB = has_next ? (const char*)g.Bt + (size_t)nxt.pn * tstep : cB;
        for (int t = 0; t < nt; t += 2) {
            const bool last = (t == nt - 2);
            const char* a1 = cA + (size_t)(t + 1) * kstep;
            const char* a2 = last ? nA : cA + (size_t)(t + 2) * kstep; const char* b2 = last ? nB : cB + (size_t)(t + 2) * kstep;
            const char* a3 = a2 + kstep; const char* b3 = b2 + kstep;
            if (last && has_next) S.a_ready(nxt);
            if constexpr (SP2) {
            PG8_LDB(B0, 0, 0); PG8_LDB(B1, 0, 1); PG8_SCHED; PG8_LDA(At, 0, 0); PG8_STAGE(PG8_SA(1, 1), a1 + hstep, voffA);
            PG8_WAIT_V(8); PG8_WAIT_L(0); PG8_BAR; PG8_MMA(0, 0, At, B0); PG8_MMA(0, 1, At, B1); PG8_BAR; PG8_SCHED;
            PG8_LDA(At, 0, 1); PG8_STAGE(PG8_SB(0, 0), b2, voffB); PG8_STAGE(PG8_SB(0, 1), b2 + hstep, voffB); PG8_STAGE(PG8_SA(0, 0), a2, voffA);
            PG8_WAIT_V(8); PG8_WAIT_L(0); PG8_BAR; PG8_MMA(1, 0, At, B0); PG8_MMA(1, 1, At, B1); PG8_BAR; PG8_SCHED;
            PG8_LDB(B0, 1, 0); PG8_LDB(B1, 1, 1); PG8_SCHED; PG8_LDA(At, 1, 0); PG8_STAGE(PG8_SA(0, 1), a2 + hstep, voffA);
            PG8_WAIT_V(8); PG8_WAIT_L(0); PG8_BAR; PG8_MMA(0, 0, At, B0); PG8_MMA(0, 1, At, B1); PG8_BAR; PG8_SCHED;
            PG8_LDA(At, 1, 1); PG8_STAGE(PG8_SB(1, 0), b3, voffB); PG8_STAGE(PG8_SB(1, 1), b3 + hstep, voffB); PG8_STAGE(PG8_SA(1, 0), a3, voffA);
            PG8_WAIT_V(8); PG8_WAIT_L(0); PG8_BAR; PG8_MMA(1, 0, At, B0); PG8_MMA(1, 1, At, B1); PG8_BAR; PG8_SCHED;
            } else {
            PG8_LDB(B0, 0, 0); PG8_SCHED; PG8_LDA(At, 0, 0); PG8_STAGE(PG8_SA(1, 1), a1 + hstep, voffA);
            PG8_WAIT_L(8); PG8_BAR; PG8_WAIT_L(0); PG8_MMA(0, 0, At, B0); PG8_BAR; PG8_SCHED;
            PG8_LDB(B1, 0, 1); PG8_STAGE(PG8_SB(0, 0), b2, voffB);
            PG8_BAR; PG8_WAIT_L(0); PG8_MMA(0, 1, At, B1); PG8_BAR;
            PG8_LDA(At, 0, 1); PG8_STAGE(PG8_SA(0, 0), a2, voffA);
            PG8_BAR; PG8_WAIT_L(0); PG8_MMA(1, 0, At, B0); PG8_BAR; PG8_SCHED;
            PG8_STAGE(PG8_SB(0, 1), b2 + hstep, voffB);
            PG8_WAIT_V(6); PG8_BAR; PG8_MMA(1, 1, At, B1); PG8_BAR;
            PG8_LDB(B0, 1, 0); PG8_SCHED; PG8_LDA(At, 1, 0); PG8_STAGE(PG8_SA(0, 1), a2 + hstep, voffA);
            PG8_WAIT_L(8); PG8_BAR; PG8_WAIT_L(0); PG8_MMA(0, 0, At, B0); PG8_BAR; PG8_SCHED;
            PG8_LDB(B1, 1, 1); PG8_STAGE(PG8_SB(1, 0), b3, voffB);
            PG8_BAR; PG8_WAIT_L(0); PG8_MMA(0, 1, At, B1); PG8_BAR;
            PG8_LDA(At, 1, 1); PG8_STAGE(PG8_SA(1, 0), a3, voffA);
            PG8_BAR; PG8_WAIT_L(0); PG8_MMA(1, 0, At, B0); PG8_BAR; PG8_SCHED;
            PG8_STAGE(PG8_SB(1, 1), b3 + hstep, voffB);
            PG8_WAIT_V(6); PG8_BAR; PG8_MMA(1, 1, At, B1); PG8_BAR;
            }
        }
        if constexpr (ALIGN_EPI) { if (wr == 0) PG8_BAR; }
        if constexpr (!Epi::AFTER_DRAIN) { E(acc, cur, wr, wc, fr, fq); S.done(cur); }
        if (!has_next) break;
#pragma unroll
        for (int a = 0; a < 2; ++a)
#pragma unroll
            for (int b = 0; b < 2; ++b)
#pragma unroll
                for (int m = 0; m < 4; ++m)
#pragma unroll
                    for (int n = 0; n < 2; ++n) acc[a][b][m][n] = (f32x4){0.f, 0.f, 0.f, 0.f};
        cur = nxt; cA = nA; cB = nB; ++ui;
        if constexpr (ALIGN_EPI) { if (wr == 1) PG8_BAR; }
    }
    PG8_WAIT_V(0);
    if constexpr (!ALIGN_EPI) { if (wr == 0) PG8_BAR; }
    PG8_BAR;
    if constexpr (Epi::AFTER_DRAIN) { E.fused(acc, cur, wr, wc, fr, fq, lds, wid, lane); S.done(cur); }
#undef PG8_SA
#undef PG8_SB
#undef PG8_STAGE
#undef PG8_LDA
#undef PG8_LDB
#undef PG8_MMA
#undef PG8_WAIT_V
#undef PG8_WAIT_L
#undef PG8_BAR
#undef PG8_SCHED
}
}

#ifndef PG8_SP2
#define PG8_SP2 true
#endif
#ifndef PG8_ALIGN
#define PG8_ALIGN true
#endif

#define LAS __attribute__((address_space(3)))
typedef unsigned short bf16_t;
typedef short bf16x8 __attribute__((ext_vector_type(8)));
typedef short s16x4 __attribute__((ext_vector_type(4)));
typedef float f32x4 __attribute__((ext_vector_type(4)));
typedef float f32x16 __attribute__((ext_vector_type(16)));
typedef unsigned u32x4 __attribute__((ext_vector_type(4)));
typedef unsigned u32x2 __attribute__((ext_vector_type(2)));
typedef float f32x2_t __attribute__((ext_vector_type(2)));
typedef __bf16 bf16x2_t __attribute__((ext_vector_type(2)));

#ifndef MK_MULTI
#define MK_MULTI 0
#endif

constexpr int BATCH = 8, SEQ = 4096, DM = 1024, DEPTH = 2, CHUNK = 64, NCH = SEQ / CHUNK, MTOK = BATCH * SEQ, INW = 4096;
constexpr int AH = 8, AD = 64, RH = 4, RD = 128, NREL = 513;
constexpr float EPS = 1e-6f, LOG2E = 1.4426950408889634f;
constexpr int NTHREADS = 512, NWAVES = 8;
constexpr int LDS_BYTES = 163840;

constexpr size_t MiB = 1u << 20;
constexpr size_t WS_WIN = 0;
constexpr size_t WS_WOUT = 16 * MiB;
constexpr size_t WS_ROT = 20 * MiB;
constexpr size_t WS_T = 22 * MiB;
constexpr size_t WS_HB = 64 * MiB;
constexpr size_t WS_PROJ = 128 * MiB;
constexpr size_t WS_XB = 384 * MiB;
constexpr size_t WS_SSQ = 41 * MiB;
constexpr size_t WS_END = 448 * MiB;

struct Args { const float* x; const int* pos; const float* ng; const float* win; const float* wout; const float* relb; const float* fg; float* out; unsigned char* ws; int ph_lo, ph_hi; };

__device__ __forceinline__ float bf2f(unsigned short u) { return __uint_as_float((unsigned)u << 16); }
__device__ __forceinline__ unsigned cvtpk(float lo, float hi) { f32x2_t v = {lo, hi}; bf16x2_t b = __builtin_convertvector(v, bf16x2_t); return __builtin_bit_cast(unsigned, b); }
__device__ __forceinline__ float ex2(float v) { return __builtin_amdgcn_exp2f(v); }
__device__ __forceinline__ float silu_f(float v) { return v * __builtin_amdgcn_rcpf(1.0f + __builtin_amdgcn_exp2f(-1.4426950408889634f * v)); }
#define MFMA32(a, b, c) __builtin_amdgcn_mfma_f32_32x32x16_bf16((a), (b), (c), 0, 0, 0)
__device__ __forceinline__ float max3f(float a, float b, float c) { float r; asm("v_max3_f32 %0, %1, %2, %3" : "=v"(r) : "v"(a), "v"(b), "v"(c)); return r; }
__device__ __forceinline__ int crow(int reg, int h) { return (reg & 3) + 8 * (reg >> 2) + 4 * h; }
__device__ __forceinline__ float wave_sum(float v) {
#pragma unroll
    for (int o = 1; o < 64; o <<= 1) v += __shfl_xor(v, o);
    return v;
}
__device__ __forceinline__ bf16x8 tr_frag(LAS const unsigned char* p, int d2) {
    const s16x4 lo = __builtin_bit_cast(s16x4, __builtin_amdgcn_ds_read_tr16_b64_v4i16((LAS s16x4*)p));
    const s16x4 hi = __builtin_bit_cast(s16x4, __builtin_amdgcn_ds_read_tr16_b64_v4i16((LAS s16x4*)(p + d2)));
    return (bf16x8){lo[0], lo[1], lo[2], lo[3], hi[0], hi[1], hi[2], hi[3]};
}
__device__ __forceinline__ bf16x8 pack8(const f32x16& x, int s) {
    u32x4 p; p.x = cvtpk(x[8 * s], x[8 * s + 1]); p.y = cvtpk(x[8 * s + 2], x[8 * s + 3]); p.z = cvtpk(x[8 * s + 4], x[8 * s + 5]); p.w = cvtpk(x[8 * s + 6], x[8 * s + 7]);
    return __builtin_bit_cast(bf16x8, p);
}

struct EpiProj {
    static constexpr bool PERM = true, AFTER_DRAIN = false;
    bf16_t* O; const float* ssq;
    __device__ __forceinline__ void operator()(const pg8::f32x4 (&acc)[2][2][4][2], const pg8::Unit& u, int wr, int wc, int fr, int fq) const {
        const int row0 = u.pm * 256 + wr * 64 + fr; const int colt = u.pn * 256; const int seg = colt >> 9;
        const int col0 = colt + wc * 32 + 8 * fq;
        const float sc = seg == 0 ? 0.125f * LOG2E : (seg == 5 ? 0.08838834764831845f : 1.0f);
        const bool act = (seg == 3) || (seg == 7);
        float rs[2][4];
#pragma unroll
        for (int ai = 0; ai < 2; ++ai)
#pragma unroll
            for (int m = 0; m < 4; ++m) rs[ai][m] = ssq[row0 + ai * 128 + m * 16];
#pragma unroll
        for (int ai = 0; ai < 2; ++ai)
#pragma unroll
            for (int m = 0; m < 4; ++m) rs[ai][m] = __builtin_amdgcn_rsqf(rs[ai][m] * (1.0f / DM) + EPS) * sc;
#pragma unroll
        for (int ai = 0; ai < 2; ++ai)
#pragma unroll
            for (int m = 0; m < 4; ++m) { bf16_t* rowp = O + (size_t)(row0 + ai * 128 + m * 16) * INW + col0;
#pragma unroll
                for (int bj = 0; bj < 2; ++bj) { pg8::f32x4 v0 = acc[ai][bj][m][0] * rs[ai][m], v1 = acc[ai][bj][m][1] * rs[ai][m];
                    if (act) {
#pragma unroll
                        for (int e = 0; e < 4; ++e) { v0[e] = silu_f(v0[e]); v1[e] = silu_f(v1[e]); } }
                    u32x4 w; w.x = cvtpk(v0[0], v0[1]); w.y = cvtpk(v0[2], v0[3]); w.z = cvtpk(v1[0], v1[1]); w.w = cvtpk(v1[2], v1[3]);
                    *(u32x4*)(rowp + bj * 128) = w; } }
    }
};
struct EpiRes {
    static constexpr bool PERM = true, AFTER_DRAIN = false;
    bf16_t* xb; float* ssq;
    __device__ __forceinline__ void operator()(const pg8::f32x4 (&acc)[2][2][4][2], const pg8::Unit& u, int wr, int wc, int fr, int fq) const {
        const int row0 = u.pm * 256 + wr * 64 + fr; const int col0 = u.pn * 256 + wc * 32 + 8 * fq;
        u32x4 bb[2][4][2];
#pragma unroll
        for (int ai = 0; ai < 2; ++ai)
#pragma unroll
            for (int m = 0; m < 4; ++m)
#pragma unroll
                for (int bj = 0; bj < 2; ++bj) bb[ai][m][bj] = *(const u32x4*)(xb + (size_t)(row0 + ai * 128 + m * 16) * DM + col0 + bj * 128);
#pragma unroll
        for (int ai = 0; ai < 2; ++ai)
#pragma unroll
            for (int m = 0; m < 4; ++m) { const size_t off = (size_t)(row0 + ai * 128 + m * 16) * DM + col0; float q = 0.f;
#pragma unroll
                for (int bj = 0; bj < 2; ++bj) {
                    const u32x4 b = bb[ai][m][bj]; f32x4 o0, o1;
                    o0[0] = __uint_as_float(b.x << 16) + acc[ai][bj][m][0][0]; o0[1] = __uint_as_float(b.x & 0xffff0000u) + acc[ai][bj][m][0][1];
                    o0[2] = __uint_as_float(b.y << 16) + acc[ai][bj][m][0][2]; o0[3] = __uint_as_float(b.y & 0xffff0000u) + acc[ai][bj][m][0][3];
                    o1[0] = __uint_as_float(b.z << 16) + acc[ai][bj][m][1][0]; o1[1] = __uint_as_float(b.z & 0xffff0000u) + acc[ai][bj][m][1][1];
                    o1[2] = __uint_as_float(b.w << 16) + acc[ai][bj][m][1][2]; o1[3] = __uint_as_float(b.w & 0xffff0000u) + acc[ai][bj][m][1][3];
                    u32x4 w; w.x = cvtpk(o0[0], o0[1]); w.y = cvtpk(o0[2], o0[3]); w.z = cvtpk(o1[0], o1[1]); w.w = cvtpk(o1[2], o1[3]);
                    *(u32x4*)(xb + off + bj * 128) = w;
#pragma unroll
                    for (int e = 0; e < 4; ++e) q += o0[e] * o0[e] + o1[e] * o1[e]; }
                q += __shfl_xor(q, 16); q += __shfl_xor(q, 32); if (fq == 0) unsafeAtomicAdd(ssq + row0 + ai * 128 + m * 16, q); }
    }
};

__device__ __forceinline__ void transpose_item(const float* W, const float* gain  , int K, int N, bf16_t* WT, LAS float* scr, int item, int lane) {
    const int nblk = N / 32, kb = item / nblk, nb = item % nblk, k0 = 64 * kb, n0 = 32 * nb;
    { f32x4 v[8]; float g[8];
#pragma unroll
      for (int it = 0; it < 8; ++it) { const int kk = it * 8 + (lane >> 3); v[it] = __builtin_nontemporal_load((const f32x4*)(W + (size_t)(k0 + kk) * N + n0 + (lane & 7) * 4)); g[it] = gain ? gain[k0 + kk] : 1.0f; }
#pragma unroll
      for (int it = 0; it < 8; ++it) { const int kk = it * 8 + (lane >> 3); LAS float* d = scr + kk * 33 + (lane & 7) * 4;
          d[0] = v[it][0] * g[it]; d[1] = v[it][1] * g[it]; d[2] = v[it][2] * g[it]; d[3] = v[it][3] * g[it]; } }
    __builtin_amdgcn_wave_barrier();
    const int c = lane & 7;
#pragma unroll
    for (int j = 0; j < 4; ++j) { const int n = (lane >> 3) + 8 * j; const LAS float* s = scr + (8 * c) * 33 + n;
        u32x4 o; o.x = cvtpk(s[0 * 33], s[1 * 33]); o.y = cvtpk(s[2 * 33], s[3 * 33]); o.z = cvtpk(s[4 * 33], s[5 * 33]); o.w = cvtpk(s[6 * 33], s[7 * 33]);
        *(u32x4*)(WT + (size_t)(n0 + n) * K + k0 + 8 * c) = o; }
    __builtin_amdgcn_wave_barrier();
}
__device__ __forceinline__ void rms_row_bf16(const float* xrow, const float* gain, bf16_t* orow, int lane) {
    const f32x4* xr = (const f32x4*)xrow + lane; const f32x4* gr = (const f32x4*)gain + lane;
    f32x4 v[4]; float s = 0.f;
#pragma unroll
    for (int j = 0; j < 4; ++j) { v[j] = xr[64 * j]; s += (v[j][0] * v[j][0] + v[j][1] * v[j][1]) + (v[j][2] * v[j][2] + v[j][3] * v[j][3]); }
    const float rstd = 1.0f / sqrtf(wave_sum(s) * (1.0f / DM) + EPS);
    u32x2* o8 = (u32x2*)orow + lane;
#pragma unroll
    for (int j = 0; j < 4; ++j) { const f32x4 g = gr[64 * j]; u32x2 w; w.x = cvtpk(v[j][0] * rstd * g[0], v[j][1] * rstd * g[1]); w.y = cvtpk(v[j][2] * rstd * g[2], v[j][3] * rstd * g[3]); o8[64 * j] = w; }
}
template <int NR>
__device__ __forceinline__ void rows_bf16_ssq(const float* xrow, bf16_t* orow, float* ssq, int lane) {
    f32x4 v[NR][4];
#pragma unroll
    for (int rr = 0; rr < NR; ++rr)
#pragma unroll
        for (int j = 0; j < 4; ++j) v[rr][j] = __builtin_nontemporal_load((const f32x4*)(xrow + (size_t)rr * DM) + lane + 64 * j);
#pragma unroll
    for (int rr = 0; rr < NR; ++rr) { float s = 0.f;
#pragma unroll
        for (int j = 0; j < 4; ++j) s += (v[rr][j][0] * v[rr][j][0] + v[rr][j][1] * v[rr][j][1]) + (v[rr][j][2] * v[rr][j][2] + v[rr][j][3] * v[rr][j][3]);
        s = wave_sum(s);
        u32x2* o8 = (u32x2*)(orow + (size_t)rr * DM) + lane;
#pragma unroll
        for (int j = 0; j < 4; ++j) { u32x2 w; w.x = cvtpk(v[rr][j][0], v[rr][j][1]); w.y = cvtpk(v[rr][j][2], v[rr][j][3]); o8[64 * j] = w; }
        if (lane == 0) ssq[rr] = s; }
}
template <int NR>
__device__ __forceinline__ void rows_load(f32x4 (&v)[NR][4], const float* xrow, int lane) {
#pragma unroll
    for (int rr = 0; rr < NR; ++rr)
#pragma unroll
        for (int j = 0; j < 4; ++j) v[rr][j] = __builtin_nontemporal_load((const f32x4*)(xrow + (size_t)rr * DM) + lane + 64 * j);
}
template <int NR>
__device__ __forceinline__ void rows_finish(const f32x4 (&v)[NR][4], bf16_t* orow, float* ssq, int lane) {
#pragma unroll
    for (int rr = 0; rr < NR; ++rr) { float s = 0.f;
#pragma unroll
        for (int j = 0; j < 4; ++j) s += (v[rr][j][0] * v[rr][j][0] + v[rr][j][1] * v[rr][j][1]) + (v[rr][j][2] * v[rr][j][2] + v[rr][j][3] * v[rr][j][3]);
        s = wave_sum(s);
        u32x2* o8 = (u32x2*)(orow + (size_t)rr * DM) + lane;
#pragma unroll
        for (int j = 0; j < 4; ++j) { u32x2 w; w.x = cvtpk(v[rr][j][0], v[rr][j][1]); w.y = cvtpk(v[rr][j][2], v[rr][j][3]); o8[64 * j] = w; }
        if (lane == 0) ssq[rr] = s; }
}
__device__ __forceinline__ void fin_load(u32x2 (&v)[4][4], float (&sq)[4], const bf16_t* xrow, const float* ssq, int lane) {
#pragma unroll
    for (int rr = 0; rr < 4; ++rr) { sq[rr] = ssq[rr];
#pragma unroll
        for (int j = 0; j < 4; ++j) v[rr][j] = __builtin_nontemporal_load((const u32x2*)(xrow + (size_t)rr * DM) + lane + 64 * j); }
}
__device__ __forceinline__ void fin_finish(const u32x2 (&v)[4][4], const float (&sq)[4], const f32x4 (&g)[4], float* orow, int lane) {
#pragma unroll
    for (int rr = 0; rr < 4; ++rr) { const float rs = 1.0f / sqrtf(sq[rr] * (1.0f / DM) + EPS); f32x4* o = (f32x4*)(orow + (size_t)rr * DM) + lane;
#pragma unroll
        for (int j = 0; j < 4; ++j) { f32x4 w;
            w[0] = __uint_as_float(v[rr][j].x << 16) * rs * g[j][0]; w[1] = __uint_as_float(v[rr][j].x & 0xffff0000u) * rs * g[j][1];
            w[2] = __uint_as_float(v[rr][j].y << 16) * rs * g[j][2]; w[3] = __uint_as_float(v[rr][j].y & 0xffff0000u) * rs * g[j][3]; __builtin_nontemporal_store(w, o + 64 * j); } }
}
__device__ __forceinline__ void rms_rows4_final(const bf16_t* xrow, const float* ssq, const float* gain, float* orow, int lane) {
    u32x2 v[4][4]; float rstd[4]; f32x4 g[4];
#pragma unroll
    for (int rr = 0; rr < 4; ++rr) { rstd[rr] = ssq[rr];
#pragma unroll
        for (int j = 0; j < 4; ++j) v[rr][j] = __builtin_nontemporal_load((const u32x2*)(xrow + (size_t)rr * DM) + lane + 64 * j); }
#pragma unroll
    for (int j = 0; j < 4; ++j) g[j] = ((const f32x4*)gain + lane)[64 * j];
#pragma unroll
    for (int rr = 0; rr < 4; ++rr) { const float rs = 1.0f / sqrtf(rstd[rr] * (1.0f / DM) + EPS); f32x4* o = (f32x4*)(orow + (size_t)rr * DM) + lane;
#pragma unroll
        for (int j = 0; j < 4; ++j) { f32x4 w;
            w[0] = __uint_as_float(v[rr][j].x << 16) * rs * g[j][0]; w[1] = __uint_as_float(v[rr][j].x & 0xffff0000u) * rs * g[j][1];
            w[2] = __uint_as_float(v[rr][j].y << 16) * rs * g[j][2]; w[3] = __uint_as_float(v[rr][j].y & 0xffff0000u) * rs * g[j][3]; __builtin_nontemporal_store(w, o + 64 * j); } }
}
__device__ __forceinline__ void rms_row_f32(const float* xrow, const float* gain, float* orow, int lane) {
    const f32x4* xr = (const f32x4*)xrow + lane; const f32x4* gr = (const f32x4*)gain + lane;
    f32x4 v[4]; float s = 0.f;
#pragma unroll
    for (int j = 0; j < 4; ++j) { v[j] = xr[64 * j]; s += (v[j][0] * v[j][0] + v[j][1] * v[j][1]) + (v[j][2] * v[j][2] + v[j][3] * v[j][3]); }
    const float rstd = 1.0f / sqrtf(wave_sum(s) * (1.0f / DM) + EPS);
    f32x4* o = (f32x4*)orow + lane;
#pragma unroll
    for (int j = 0; j < 4; ++j) { const f32x4 g = gr[64 * j]; f32x4 w; w[0] = v[j][0] * rstd * g[0]; w[1] = v[j][1] * rstd * g[1]; w[2] = v[j][2] * rstd * g[2]; w[3] = v[j][3] * rstd * g[3]; o[64 * j] = w; }
}
__device__ __forceinline__ void rot_entry(int pos, int j, float& c, float& s) {
    const float invf = (float)exp2(-(double)j * (13.287712379549449 / 63.0));
    const float ang = (float)pos * invf;
    const double x = (double)ang;
    const double k = rint(x * 0.15915494309189535);
    const double r = x - k * 6.283185307179586;
    const double r2 = r * r; double sp = 1.0, cp = 1.0;
#pragma unroll
    for (int n = 16; n >= 1; --n) { sp = 1.0 - sp * r2 * (1.0 / (double)((2 * n) * (2 * n + 1))); cp = 1.0 - cp * r2 * (1.0 / (double)((2 * n - 1) * (2 * n))); }
    s = (float)(r * sp); c = (float)cp;
}


__device__ __forceinline__ void lds_read_k8(bf16x8 (&kf)[8], unsigned addr) {
    asm volatile("ds_read_b128 %0, %8\n\tds_read_b128 %1, %8 offset:4608\n\tds_read_b128 %2, %8 offset:32\n\tds_read_b128 %3, %8 offset:4640\n\t"
                 "ds_read_b128 %4, %8 offset:64\n\tds_read_b128 %5, %8 offset:4672\n\tds_read_b128 %6, %8 offset:96\n\tds_read_b128 %7, %8 offset:4704\n\ts_waitcnt lgkmcnt(0)"
                 : "=&v"(kf[0]), "=&v"(kf[1]), "=&v"(kf[2]), "=&v"(kf[3]), "=&v"(kf[4]), "=&v"(kf[5]), "=&v"(kf[6]), "=&v"(kf[7]) : "v"(addr) : "memory");
}
__device__ __forceinline__ void lds_read_v8(bf16x8 (&vf)[8], unsigned addr) {
    s16x4 a0, a1, a2, a3, a4, a5, a6, a7, b0, b1, b2, b3, b4, b5, b6, b7;
    asm volatile("ds_read_b64_tr_b16 %0, %16\n\tds_read_b64_tr_b16 %8, %16 offset:1536\n\t"
                 "ds_read_b64_tr_b16 %1, %16 offset:64\n\tds_read_b64_tr_b16 %9, %16 offset:1600\n\t"
                 "ds_read_b64_tr_b16 %2, %16 offset:3072\n\tds_read_b64_tr_b16 %10, %16 offset:4608\n\t"
                 "ds_read_b64_tr_b16 %3, %16 offset:3136\n\tds_read_b64_tr_b16 %11, %16 offset:4672\n\t"
                 "ds_read_b64_tr_b16 %4, %16 offset:6144\n\tds_read_b64_tr_b16 %12, %16 offset:7680\n\t"
                 "ds_read_b64_tr_b16 %5, %16 offset:6208\n\tds_read_b64_tr_b16 %13, %16 offset:7744\n\t"
                 "ds_read_b64_tr_b16 %6, %16 offset:9216\n\tds_read_b64_tr_b16 %14, %16 offset:10752\n\t"
                 "ds_read_b64_tr_b16 %7, %16 offset:9280\n\tds_read_b64_tr_b16 %15, %16 offset:10816\n\ts_waitcnt lgkmcnt(0)"
                 : "=&v"(a0), "=&v"(a1), "=&v"(a2), "=&v"(a3), "=&v"(a4), "=&v"(a5), "=&v"(a6), "=&v"(a7),
                   "=&v"(b0), "=&v"(b1), "=&v"(b2), "=&v"(b3), "=&v"(b4), "=&v"(b5), "=&v"(b6), "=&v"(b7) : "v"(addr) : "memory");
#define CAT_(lo, hi) __builtin_shufflevector(lo, hi, 0, 1, 2, 3, 4, 5, 6, 7)
    vf[0] = CAT_(a0, b0); vf[1] = CAT_(a1, b1); vf[2] = CAT_(a2, b2); vf[3] = CAT_(a3, b3); vf[4] = CAT_(a4, b4); vf[5] = CAT_(a5, b5); vf[6] = CAT_(a6, b6); vf[7] = CAT_(a7, b7);
#undef CAT_
}
__device__ __forceinline__ void lds_read_v8_nowait(bf16x8 (&vf)[8], unsigned addr) {
    s16x4 a0, a1, a2, a3, a4, a5, a6, a7, b0, b1, b2, b3, b4, b5, b6, b7;
    asm volatile("ds_read_b64_tr_b16 %0, %16\n\tds_read_b64_tr_b16 %8, %16 offset:1536\n\t"
                 "ds_read_b64_tr_b16 %1, %16 offset:64\n\tds_read_b64_tr_b16 %9, %16 offset:1600\n\t"
                 "ds_read_b64_tr_b16 %2, %16 offset:3072\n\tds_read_b64_tr_b16 %10, %16 offset:4608\n\t"
                 "ds_read_b64_tr_b16 %3, %16 offset:3136\n\tds_read_b64_tr_b16 %11, %16 offset:4672\n\t"
                 "ds_read_b64_tr_b16 %4, %16 offset:6144\n\tds_read_b64_tr_b16 %12, %16 offset:7680\n\t"
                 "ds_read_b64_tr_b16 %5, %16 offset:6208\n\tds_read_b64_tr_b16 %13, %16 offset:7744\n\t"
                 "ds_read_b64_tr_b16 %6, %16 offset:9216\n\tds_read_b64_tr_b16 %14, %16 offset:10752\n\t"
                 "ds_read_b64_tr_b16 %7, %16 offset:9280\n\tds_read_b64_tr_b16 %15, %16 offset:10816"
                 : "=&v"(a0), "=&v"(a1), "=&v"(a2), "=&v"(a3), "=&v"(a4), "=&v"(a5), "=&v"(a6), "=&v"(a7),
                   "=&v"(b0), "=&v"(b1), "=&v"(b2), "=&v"(b3), "=&v"(b4), "=&v"(b5), "=&v"(b6), "=&v"(b7) : "v"(addr) : "memory");
#define CAT_(lo, hi) __builtin_shufflevector(lo, hi, 0, 1, 2, 3, 4, 5, 6, 7)
    vf[0] = CAT_(a0, b0); vf[1] = CAT_(a1, b1); vf[2] = CAT_(a2, b2); vf[3] = CAT_(a3, b3); vf[4] = CAT_(a4, b4); vf[5] = CAT_(a5, b5); vf[6] = CAT_(a6, b6); vf[7] = CAT_(a7, b7);
#undef CAT_
}
__device__ __forceinline__ void lds_wait8(bf16x8 (&vf)[8]) {
    asm volatile("s_waitcnt lgkmcnt(0)" : "+v"(vf[0]), "+v"(vf[1]), "+v"(vf[2]), "+v"(vf[3]), "+v"(vf[4]), "+v"(vf[5]), "+v"(vf[6]), "+v"(vf[7]) : : "memory");
}
__device__ __forceinline__ unsigned lds_addr(LAS const unsigned char* p) { return (unsigned)(uintptr_t)p; }
constexpr int PK = 144, PV = 192;
constexpr int ATT_BUF = 64 * PK + 64 * PV;
constexpr int ATT_NBUF = 2;
constexpr int ATT_BIAS = ATT_NBUF * ATT_BUF;
constexpr int BT_STRIDE = 656;
constexpr int ATT_END = ATT_BIAS + 4 * BT_STRIDE * 4;
constexpr int ATT_OST = ATT_END;
static_assert(ATT_OST + 8 * 32 * 144 <= 131072, "attention LDS");
__device__ __forceinline__ void attn_block_units(const bf16_t* __restrict__ proj, bf16_t* __restrict__ y, const float* __restrict__ relb, LAS unsigned char* lds, int bx, int G, int tid) {
    const int lane = tid & 63, wid = __builtin_amdgcn_readfirstlane(tid >> 6), r = lane & 31, hi = lane >> 5;
    const int ci = wid >> 1, qh = wid & 1;
    LAS float* biasT = (LAS float*)(lds + ATT_BIAS);
    const int srow = tid >> 3, scc = tid & 7;
    LAS unsigned char* stk = lds + srow * PK + scc * 16; LAS unsigned char* stv = lds + 64 * PK + srow * PV + scc * 16;
    const int qi = qh * 32 + r;
    const int i16 = lane & 15, tq_ = i16 >> 2, tp = i16 & 3, blk = (lane >> 4) & 1;
    LAS const unsigned char* kbase = lds + r * PK + 16 * hi;
    LAS const unsigned char* vperm = lds + 64 * PK + (4 * hi + tq_) * PV + (16 * blk + 4 * tp) * 2;
    const int xb = 63 - qi + 4 * hi;
    LAS const float* bbase = biasT + (xb & 3) * BT_STRIDE + (xb & ~3);
    if (bx >= 1024) return;
#define ATT_UNIT(u, b_, h_, n0_) const int b_ = (u) & 7, h_ = ((u) >> 3) & 7, n0_ = ((u) >> 6) * 4
    int u = bx; int hprev = -1;
    bf16x8 qf[4]; u32x4 kreg, vreg;
    { ATT_UNIT(u, b, h, n0); const int c0 = n0 >= 8 ? 0 : 8 - n0;
      const bf16_t* qp = proj + ((size_t)b * SEQ + (n0 + ci) * 64 + qh * 32 + r) * INW + h * 64 + 8 * hi;
#pragma unroll
      for (int s = 0; s < 4; ++s) qf[s] = *(const bf16x8*)(qp + 16 * s);
      const bf16_t* gk = proj + ((size_t)b * SEQ + (size_t)(n0 - 8 + c0) * 64 + srow) * INW + 512 + h * 64 + scc * 8;
      kreg = *(const u32x4*)gk; vreg = *(const u32x4*)(gk + 512); }
#pragma unroll 1
    for (; u < 1024; u += G) {
        ATT_UNIT(u, b, h, n0); const int n = n0 + ci;
        if (h != hprev) { hprev = h;
            for (int e = tid; e < 4 * BT_STRIDE; e += NTHREADS) { const int sh = e / BT_STRIDE, x = e - sh * BT_STRIDE + sh; const int dist = 575 - x; int idx = (dist < 256 ? dist : 256) + 256; idx = idx < 0 ? 0 : idx;
                biasT[e] = relb[h * NREL + idx] * LOG2E; } }
        const size_t tq = (size_t)b * SEQ + n * 64 + qh * 32;
        const int c0 = n0 >= 8 ? 0 : 8 - n0;
        const bf16_t* gk = proj + ((size_t)b * SEQ + (size_t)(n0 - 8 + c0) * 64 + srow) * INW + 512 + h * 64 + scc * 8;
        *(LAS u32x4*)stk = kreg; *(LAS u32x4*)stv = vreg;
        u32x4 kreg2, vreg2;
        { gk += (size_t)64 * INW; kreg = *(const u32x4*)gk; vreg = *(const u32x4*)(gk + 512); kreg2 = kreg; vreg2 = vreg; }
        __syncthreads();
        f32x16 o0, o1;
#pragma unroll
        for (int i = 0; i < 16; ++i) { o0[i] = 0.f; o1[i] = 0.f; }
        float m = -1e30f, l = 0.f;
        u32x4 gq[4];
        bf16x8 qn[4];
#pragma unroll
        for (int i = 0; i < 4; ++i) { gq[i] = (u32x4){0u, 0u, 0u, 0u}; qn[i] = qf[i]; }
        const bf16_t* gp = proj + (tq + (lane >> 3)) * INW + 1536 + h * 64 + (lane & 7) * 8;
        const bool has_next = (u + G) < 1024;
#pragma unroll 1
        for (int c = c0; c < 12; ++c) {
            const int boff = ((c - c0) & 1) * ATT_BUF;
            if (c < 10) { gk += (size_t)64 * INW; kreg2 = *(const u32x4*)gk; vreg2 = *(const u32x4*)(gk + 512); }
            if (c == 11) {
#pragma unroll
                for (int it = 0; it < 4; ++it) gq[it] = *(const u32x4*)(gp + (size_t)it * 8 * INW);
                if (has_next) { ATT_UNIT(u + G, b2, h2, n02); const int c02 = n02 >= 8 ? 0 : 8 - n02;
                    const bf16_t* qp = proj + ((size_t)b2 * SEQ + (n02 + ci) * 64 + qh * 32 + r) * INW + h2 * 64 + 8 * hi;
#pragma unroll
                    for (int s = 0; s < 4; ++s) qn[s] = *(const bf16x8*)(qp + 16 * s);
                    const bf16_t* gk2 = proj + ((size_t)b2 * SEQ + (size_t)(n02 - 8 + c02) * 64 + srow) * INW + 512 + h2 * 64 + scc * 8;
                    kreg = *(const u32x4*)gk2; vreg = *(const u32x4*)(gk2 + 512); } }
            const int j = c - ci;
            if (j >= 0 && j < 9) {
                f32x16 s0, s1;
                { LAS const float* bp = bbase + j * 64;
#pragma unroll
                  for (int g = 0; g < 4; ++g) { const f32x4 b0 = *(LAS const f32x4*)(bp + 8 * g), b1 = *(LAS const f32x4*)(bp + 32 + 8 * g);
#pragma unroll
                      for (int e = 0; e < 4; ++e) { s0[4 * g + e] = b0[e]; s1[4 * g + e] = b1[e]; } } }
                { bf16x8 kf[8]; lds_read_k8(kf, lds_addr(kbase + boff));
#pragma unroll
                  for (int s = 0; s < 4; ++s) { s0 = MFMA32(kf[2 * s], qf[s], s0); s1 = MFMA32(kf[2 * s + 1], qf[s], s1); } }
                bf16x8 vf[8]; lds_read_v8_nowait(vf, lds_addr(vperm + boff));
                { float mx = fmaxf(s0[0], s1[0]), mx2 = fmaxf(s0[1], s1[1]);
#pragma unroll
                  for (int reg = 2; reg < 16; reg += 2) { mx = max3f(mx, s0[reg], s1[reg]); mx2 = max3f(mx2, s0[reg + 1], s1[reg + 1]); }
                  mx = fmaxf(mx, mx2);
                  mx = fmaxf(mx, __shfl_xor(mx, 32));
                  const bool grow = (mx - m) > 8.0f;
                  if (__any(grow)) { const float mnew = grow ? mx : m, alpha = ex2(m - mnew); m = mnew; l *= alpha;
#pragma unroll
                      for (int reg = 0; reg < 16; ++reg) { o0[reg] *= alpha; o1[reg] *= alpha; } }
                  float ls0 = 0.f, ls1 = 0.f;
#pragma unroll
                  for (int reg = 0; reg < 16; ++reg) { s0[reg] = ex2(s0[reg] - m); s1[reg] = ex2(s1[reg] - m); ls0 += s0[reg]; ls1 += s1[reg]; }
                  l += ls0 + ls1; }
                { const bf16x8 p00 = pack8(s0, 0), p01 = pack8(s0, 1), p10 = pack8(s1, 0), p11 = pack8(s1, 1);
                  lds_wait8(vf);
                  o0 = MFMA32(vf[0], p00, o0); o1 = MFMA32(vf[1], p00, o1);
                  o0 = MFMA32(vf[2], p01, o0); o1 = MFMA32(vf[3], p01, o1);
                  o0 = MFMA32(vf[4], p10, o0); o1 = MFMA32(vf[5], p10, o1);
                  o0 = MFMA32(vf[6], p11, o0); o1 = MFMA32(vf[7], p11, o1); }
            }
            if (c < 11) { const int woff = (((c - c0) & 1) ^ 1) * ATT_BUF; *(LAS u32x4*)(stk + woff) = kreg; *(LAS u32x4*)(stv + woff) = vreg; kreg = kreg2; vreg = vreg2; }
            __syncthreads();
        }
        l += __shfl_xor(l, 32);
        const float inv = 1.0f / l;
        { LAS unsigned char* ot = lds + ATT_OST + wid * (32 * 144);
          __builtin_amdgcn_wave_barrier();
#pragma unroll
          for (int it = 0; it < 4; ++it) *(LAS u32x4*)(ot + (it * 8 + (lane >> 3)) * 144 + (lane & 7) * 16) = gq[it];
          __builtin_amdgcn_wave_barrier();
          LAS unsigned char* orow = ot + r * 144 + 8 * hi;
#pragma unroll
          for (int g = 0; g < 4; ++g) {
              const u32x2 g0 = *(LAS const u32x2*)(orow + 16 * g), g1 = *(LAS const u32x2*)(orow + 64 + 16 * g);
              u32x2 w0, w1;
              w0.x = cvtpk(o0[4 * g] * inv * bf2f((unsigned short)(g0.x & 0xffff)), o0[4 * g + 1] * inv * bf2f((unsigned short)(g0.x >> 16)));
              w0.y = cvtpk(o0[4 * g + 2] * inv * bf2f((unsigned short)(g0.y & 0xffff)), o0[4 * g + 3] * inv * bf2f((unsigned short)(g0.y >> 16)));
              w1.x = cvtpk(o1[4 * g] * inv * bf2f((unsigned short)(g1.x & 0xffff)), o1[4 * g + 1] * inv * bf2f((unsigned short)(g1.x >> 16)));
              w1.y = cvtpk(o1[4 * g + 2] * inv * bf2f((unsigned short)(g1.y & 0xffff)), o1[4 * g + 3] * inv * bf2f((unsigned short)(g1.y >> 16)));
              *(LAS u32x2*)(orow + 16 * g) = w0; *(LAS u32x2*)(orow + 64 + 16 * g) = w1;
          }
          __builtin_amdgcn_wave_barrier();
          bf16_t* yp = y + (tq + (lane >> 3)) * DM + h * 64 + (lane & 7) * 8;
#pragma unroll
          for (int it = 0; it < 4; ++it) *(u32x4*)(yp + (size_t)it * 8 * DM) = *(LAS const u32x4*)(ot + (it * 8 + (lane >> 3)) * 144 + (lane & 7) * 16);
          __builtin_amdgcn_wave_barrier(); }
#pragma unroll
        for (int i = 0; i < 4; ++i) qf[i] = qn[i];
    }
#undef ATT_UNIT
}

constexpr int RP = 272;
constexpr int RPT = 320;
constexpr int R_QS = 0, R_KS = 64 * RP, R_KD = 2 * 64 * RP, R_VS = R_KD + 64 * RPT, R_ST = R_VS + 64 * RPT, R_RED = R_ST + 128 * RP, R_END = R_RED + 4 * 64 * 4;
static_assert(R_END <= 163840 - 512, "retention LDS");
__device__ __forceinline__ float log2gamma(int h) { return log2f(1.0f - ex2(-5.0f - (float)h)); }

__device__ __forceinline__ void unpack8(const u32x4 v, float (&f)[8]) {
    f[0] = __uint_as_float(v.x << 16); f[1] = __uint_as_float(v.x & 0xffff0000u); f[2] = __uint_as_float(v.y << 16); f[3] = __uint_as_float(v.y & 0xffff0000u);
    f[4] = __uint_as_float(v.z << 16); f[5] = __uint_as_float(v.z & 0xffff0000u); f[6] = __uint_as_float(v.w << 16); f[7] = __uint_as_float(v.w & 0xffff0000u);
}
__device__ __forceinline__ u32x4 packf8(const float (&f)[8]) { u32x4 w; w.x = cvtpk(f[0], f[1]); w.y = cvtpk(f[2], f[3]); w.z = cvtpk(f[4], f[5]); w.w = cvtpk(f[6], f[7]); return w; }

#define RD8_OUT(f) "=&v"(f[0]), "=&v"(f[1]), "=&v"(f[2]), "=&v"(f[3]), "=&v"(f[4]), "=&v"(f[5]), "=&v"(f[6]), "=&v"(f[7])
__device__ __forceinline__ void lds_rd8(bf16x8 (&f)[8], unsigned addr) {
    asm volatile("ds_read_b128 %0, %8\n\tds_read_b128 %1, %8 offset:32\n\tds_read_b128 %2, %8 offset:64\n\tds_read_b128 %3, %8 offset:96\n\t"
                 "ds_read_b128 %4, %8 offset:128\n\tds_read_b128 %5, %8 offset:160\n\tds_read_b128 %6, %8 offset:192\n\tds_read_b128 %7, %8 offset:224\n\ts_waitcnt lgkmcnt(0)"
                 : RD8_OUT(f) : "v"(addr) : "memory");
}
__device__ __forceinline__ void lds_rd16(bf16x8 (&f)[8], bf16x8 (&g)[8], unsigned a0, unsigned a1) {
    asm volatile("ds_read_b128 %0, %16\n\tds_read_b128 %1, %16 offset:32\n\tds_read_b128 %2, %16 offset:64\n\tds_read_b128 %3, %16 offset:96\n\t"
                 "ds_read_b128 %4, %16 offset:128\n\tds_read_b128 %5, %16 offset:160\n\tds_read_b128 %6, %16 offset:192\n\tds_read_b128 %7, %16 offset:224\n\t"
                 "ds_read_b128 %8, %17\n\tds_read_b128 %9, %17 offset:32\n\tds_read_b128 %10, %17 offset:64\n\tds_read_b128 %11, %17 offset:96\n\t"
                 "ds_read_b128 %12, %17 offset:128\n\tds_read_b128 %13, %17 offset:160\n\tds_read_b128 %14, %17 offset:192\n\tds_read_b128 %15, %17 offset:224\n\ts_waitcnt lgkmcnt(0)"
                 : RD8_OUT(f), RD8_OUT(g) : "v"(a0), "v"(a1) : "memory");
}
template <int S, int H>
__device__ __forceinline__ void lds_tr4(bf16x8 (&f)[4], unsigned addr) {
    s16x4 a0, a1, a2, a3, b0, b1, b2, b3;
    asm volatile("ds_read_b64_tr_b16 %0, %8\n\tds_read_b64_tr_b16 %4, %8 offset:%c9\n\tds_read_b64_tr_b16 %1, %8 offset:%c10\n\tds_read_b64_tr_b16 %5, %8 offset:%c11\n\t"
                 "ds_read_b64_tr_b16 %2, %8 offset:%c12\n\tds_read_b64_tr_b16 %6, %8 offset:%c13\n\tds_read_b64_tr_b16 %3, %8 offset:%c14\n\tds_read_b64_tr_b16 %7, %8 offset:%c15\n\ts_waitcnt lgkmcnt(0)"
                 : "=&v"(a0), "=&v"(a1), "=&v"(a2), "=&v"(a3), "=&v"(b0), "=&v"(b1), "=&v"(b2), "=&v"(b3)
                 : "v"(addr), "i"(H), "i"(S), "i"(S + H), "i"(2 * S), "i"(2 * S + H), "i"(3 * S), "i"(3 * S + H) : "memory");
#define CAT_(lo, hi) __builtin_shufflevector(lo, hi, 0, 1, 2, 3, 4, 5, 6, 7)
    f[0] = CAT_(a0, b0); f[1] = CAT_(a1, b1); f[2] = CAT_(a2, b2); f[3] = CAT_(a3, b3);
#undef CAT_
}

struct RetRegs { u32x4 q1, q2, k1, k2, v1, v2, csa, csb; };
template <bool WITH_Q>
__device__ __forceinline__ void ret_load_qkv(RetRegs& R, const bf16_t* __restrict__ proj, int b, int h, int n, int tid) {
    const int t = tid >> 3, c0 = (tid & 7) * 8;
    const size_t row = (size_t)b * SEQ + n * 64 + t;
    const bf16_t* pr = proj + row * INW + h * 128 + c0;
    if (WITH_Q) {
        R.k1 = __builtin_nontemporal_load((const u32x4*)(pr + 2560)); R.k2 = __builtin_nontemporal_load((const u32x4*)(pr + 2560 + 64));
        R.v1 = __builtin_nontemporal_load((const u32x4*)(pr + 3072)); R.v2 = __builtin_nontemporal_load((const u32x4*)(pr + 3072 + 64));
        R.q1 = __builtin_nontemporal_load((const u32x4*)(pr + 2048)); R.q2 = __builtin_nontemporal_load((const u32x4*)(pr + 2048 + 64));
    } else {
        R.k1 = *(const u32x4*)(pr + 2560); R.k2 = *(const u32x4*)(pr + 2560 + 64);
        R.v1 = *(const u32x4*)(pr + 3072); R.v2 = *(const u32x4*)(pr + 3072 + 64);
    }
}
__device__ __forceinline__ void ret_load_cs(RetRegs& R, const float* __restrict__ rot, int n, int tid) {
    const int t = tid >> 3, c0 = (tid & 7) * 8; const int spos = n * 64 + t;
    const unsigned* cp = (const unsigned*)rot + (size_t)spos * 64 + c0;
    R.csa = *(const u32x4*)cp; R.csb = *(const u32x4*)(cp + 4);
}
template <bool WITH_Q>
__device__ __forceinline__ void ret_load(RetRegs& R, const bf16_t* __restrict__ proj, const float* __restrict__ rot, int b, int h, int n, int tid) {
    ret_load_qkv<WITH_Q>(R, proj, b, h, n, tid); ret_load_cs(R, rot, n, tid);
}
template <bool WITH_Q>
__device__ __forceinline__ void ret_store(const RetRegs& R, LAS unsigned char* lds, float l2g, int tid) {
    const int t = tid >> 3, c0 = (tid & 7) * 8;
    float cs[8], sn[8];
#pragma unroll
    for (int e = 0; e < 4; ++e) { cs[e] = __uint_as_float(R.csa[e] << 16); sn[e] = __uint_as_float(R.csa[e] & 0xffff0000u); cs[4 + e] = __uint_as_float(R.csb[e] << 16); sn[4 + e] = __uint_as_float(R.csb[e] & 0xffff0000u); }
    float a[8], bb[8], o1[8], o2[8];
    unpack8(R.k1, a); unpack8(R.k2, bb);
#pragma unroll
    for (int e = 0; e < 8; ++e) { o1[e] = a[e] * cs[e] - bb[e] * sn[e]; o2[e] = a[e] * sn[e] + bb[e] * cs[e]; }
    LAS unsigned char* rowp = lds + t * RP + c0 * 2;
    LAS unsigned char* rowt = lds + t * RPT + c0 * 2;
    if (WITH_Q) { *(LAS u32x4*)(rowp + R_KS) = packf8(o1); *(LAS u32x4*)(rowp + R_KS + 128) = packf8(o2); }
    const float kd = ex2(l2g * (float)(63 - t));
#pragma unroll
    for (int e = 0; e < 8; ++e) { o1[e] *= kd; o2[e] *= kd; }
    *(LAS u32x4*)(rowt + R_KD) = packf8(o1); *(LAS u32x4*)(rowt + R_KD + 128) = packf8(o2);
    *(LAS u32x4*)(rowt + R_VS) = R.v1; *(LAS u32x4*)(rowt + R_VS + 128) = R.v2;
    if (WITH_Q) {
        unpack8(R.q1, a); unpack8(R.q2, bb);
#pragma unroll
        for (int e = 0; e < 8; ++e) { o1[e] = a[e] * cs[e] - bb[e] * sn[e]; o2[e] = a[e] * sn[e] + bb[e] * cs[e]; }
        *(LAS u32x4*)(rowp + R_QS) = packf8(o1); *(LAS u32x4*)(rowp + R_QS + 128) = packf8(o2);
    }
}
__device__ __forceinline__ void ret_state_update(f32x16 (&accS)[2], LAS const unsigned char* lds, int wid, int lane, float cd) {
    const int hi = lane >> 5, i16 = lane & 15, tq_ = i16 >> 2, tp = i16 & 3, blk = (lane >> 4) & 1;
    const int dvb = wid >> 1, dkb0 = (wid & 1) * 2;
    LAS const unsigned char* nat = lds + (8 * hi + tq_) * RPT + (16 * blk + 4 * tp) * 2;
    bf16x8 va[4], k0[4], k1[4];
    lds_tr4<16 * RPT, 4 * RPT>(va, lds_addr(nat + R_VS + dvb * 64));
    lds_tr4<16 * RPT, 4 * RPT>(k0, lds_addr(nat + R_KD + dkb0 * 64));
    lds_tr4<16 * RPT, 4 * RPT>(k1, lds_addr(nat + R_KD + (dkb0 + 1) * 64));
#pragma unroll
    for (int i = 0; i < 16; ++i) { accS[0][i] *= cd; accS[1][i] *= cd; }
#pragma unroll
    for (int s = 0; s < 4; ++s) { accS[0] = MFMA32(va[s], k0[s], accS[0]); accS[1] = MFMA32(va[s], k1[s], accS[1]); }
}
constexpr int R_GT = R_RED + 1024;
static_assert(R_GT + 64 * RP <= 163840 - 512, "retention LDS");
constexpr int R_MASK = R_GT + 64 * RP;
static_assert(R_MASK + 64 * 272 <= 163840 - 512, "retention LDS");
constexpr int R_IMG = 2 * 64 * RPT;
static_assert(R_IMG + R_VS + 64 * RPT <= 163840 - 512, "retention LDS");
__device__ __forceinline__ void ret_r1_item(const bf16_t* __restrict__ proj, const float* __restrict__ rot, float* __restrict__ Tws, LAS unsigned char* lds, int item, int tid) {
    const int b = item & 7, h = (item >> 3) & 3, seg = item >> 5;
    const int wid = tid >> 6, lane = tid & 63;
    const float l2g = log2gamma(h), cd = ex2(l2g * 64.0f);
    f32x16 accS[2];
#pragma unroll
    for (int i = 0; i < 16; ++i) { accS[0][i] = 0.f; accS[1][i] = 0.f; }
    RetRegs RA, RB;
    ret_load<false>(RA, proj, rot, b, h, seg * 8, tid);
    ret_load<false>(RB, proj, rot, b, h, seg * 8 + 1, tid);
    ret_store<false>(RA, lds, l2g, tid);
    __syncthreads();
#pragma unroll 1
    for (int c = 0; c < 8; c += 2) {
        if (c + 2 < 8) ret_load<false>(RA, proj, rot, b, h, seg * 8 + c + 2, tid);
        ret_state_update(accS, lds, wid, lane, cd);
        ret_store<false>(RB, lds + R_IMG, l2g, tid);
        __syncthreads();
        if (c + 3 < 8) ret_load<false>(RB, proj, rot, b, h, seg * 8 + c + 3, tid);
        ret_state_update(accS, lds + R_IMG, wid, lane, cd);
        if (c + 2 < 8) ret_store<false>(RA, lds, l2g, tid);
        __syncthreads();
    }
    unsigned* tp = (unsigned*)Tws + (size_t)item * 8192 + (size_t)wid * 1024 + lane;
#pragma unroll
    for (int kk = 0; kk < 2; ++kk)
#pragma unroll
        for (int i = 0; i < 8; ++i) tp[(kk * 8 + i) * 64] = cvtpk(accS[kk][2 * i], accS[kk][2 * i + 1]);
}
__device__ __forceinline__ void ret_r2_item(const bf16_t* __restrict__ proj, const float* __restrict__ rot, const float* __restrict__ Tws, bf16_t* __restrict__ y, LAS unsigned char* lds, int item, int tid) {
    const int b = item & 7, h = (item >> 3) & 3, seg = item >> 5;
    const int wid = tid >> 6, lane = tid & 63, r = lane & 31, hi = lane >> 5;
    const int dvb = wid >> 1, ib = wid & 1, dkb0 = (wid & 1) * 2;
    const float l2g = log2gamma(h), cd = ex2(l2g * 64.0f), cd8 = ex2(l2g * 512.0f);
    RetRegs R;
    ret_load<true>(R, proj, rot, b, h, seg * 8, tid);
    f32x16 accS[2];
#pragma unroll
    for (int i = 0; i < 16; ++i) { accS[0][i] = 0.f; accS[1][i] = 0.f; }
    { unsigned tv[7][16];
#pragma unroll
      for (int sp = 0; sp < 7; ++sp) if (sp < seg) {
          const unsigned* tp = (const unsigned*)Tws + (size_t)(b + 8 * h + 32 * sp) * 8192 + (size_t)wid * 1024 + lane;
#pragma unroll
          for (int i = 0; i < 16; ++i) tv[sp][i] = tp[i * 64]; }
#pragma unroll
      for (int sp = 0; sp < 7; ++sp) if (sp < seg) {
          const float w = ex2(l2g * 512.0f * (float)(seg - 1 - sp));
#pragma unroll
          for (int kk = 0; kk < 2; ++kk)
#pragma unroll
              for (int i = 0; i < 8; ++i) { accS[kk][2 * i] += w * __uint_as_float(tv[sp][kk * 8 + i] << 16); accS[kk][2 * i + 1] += w * __uint_as_float(tv[sp][kk * 8 + i] & 0xffff0000u); } } }
    const int i16 = lane & 15, tq_ = i16 >> 2, tp_ = i16 & 3, blk = (lane >> 4) & 1;
    LAS const unsigned char* vperm = lds + R_VS + (4 * hi + tq_) * RPT + (dvb * 32 + 16 * blk + 4 * tp_) * 2;
    LAS float* red = (LAS float*)(lds + R_RED);
    const int itok = ib * 32 + r;
    const float qdec = ex2(l2g * (float)(itok + 1));
    const int gt_t = tid >> 3, gt_c = (tid & 7) * 8;
    u32x4 ga, gb;
    { const bf16_t* gp = proj + ((size_t)b * SEQ + seg * 512 + gt_t) * INW + 3584 + h * 128 + gt_c;
      ga = *(const u32x4*)gp; gb = *(const u32x4*)(gp + 64); }
    LAS unsigned char* gtp = lds + R_GT + gt_t * RP + gt_c * 2;
    { LAS float* mk = (LAS float*)(lds + R_MASK);
      for (int e = tid; e < 64 * 64; e += NTHREADS) { const int i = e >> 6, j = e & 63, d = i - j; mk[i * 68 + j] = ex2(l2g * (float)(d < 0 ? -d : d)); } }
    LAS const float* mrow = (LAS const float*)(lds + R_MASK) + itok * 68 + 4 * hi;
#pragma unroll 1
    for (int c = 0; c < 8; ++c) {
        const int n = seg * 8 + c;
#pragma unroll
        for (int kk = 0; kk < 2; ++kk)
#pragma unroll
            for (int g = 0; g < 4; ++g) { u32x2 w; w.x = cvtpk(accS[kk][4 * g], accS[kk][4 * g + 1]); w.y = cvtpk(accS[kk][4 * g + 2], accS[kk][4 * g + 3]);
                *(LAS u32x2*)(lds + R_ST + ((dkb0 + kk) * 32 + r) * RP + (dvb * 32 + 8 * g + 4 * hi) * 2) = w; }
        ret_store<true>(R, lds, l2g, tid);
        *(LAS u32x4*)gtp = ga; *(LAS u32x4*)(gtp + 128) = gb;
        __syncthreads();
        const size_t row = (size_t)b * SEQ + n * 64 + itok;
        if (c < 7) ret_load_qkv<true>(R, proj, b, h, n + 1, tid);
        bf16x8 qf[8];
        f32x16 a0, a1, o;
#pragma unroll
        for (int i = 0; i < 16; ++i) { a0[i] = 0.f; a1[i] = 0.f; o[i] = 0.f; }
        { bf16x8 kf[8];
          lds_rd16(qf, kf, lds_addr(lds + R_QS + itok * RP + 16 * hi), lds_addr(lds + R_KS + r * RP + 16 * hi));
#pragma unroll
          for (int s = 0; s < 8; ++s) a0 = MFMA32(kf[s], qf[s], a0); }
        { bf16x8 kf[8];
          lds_rd8(kf, lds_addr(lds + R_KS + (32 + r) * RP + 16 * hi));
#pragma unroll
          for (int s = 0; s < 8; ++s) a1 = MFMA32(kf[s], qf[s], a1); }
        { bf16x8 sf[4];
          LAS const unsigned char* snat = lds + R_ST + (8 * hi + tq_) * RP + (dvb * 32 + 16 * blk + 4 * tp_) * 2;
          lds_tr4<16 * RP, 4 * RP>(sf, lds_addr(snat));
#pragma unroll
          for (int s = 0; s < 4; ++s) o = MFMA32(sf[s], qf[s], o);
          lds_tr4<16 * RP, 4 * RP>(sf, lds_addr(snat + 64 * RP));
#pragma unroll
          for (int s = 0; s < 4; ++s) o = MFMA32(sf[s], qf[4 + s], o); }
        if (c < 7) ret_load_cs(R, rot, n + 1, tid);
#pragma unroll
        for (int g = 0; g < 4; ++g) { const f32x4 m0 = *(LAS const f32x4*)(mrow + 8 * g), m1 = *(LAS const f32x4*)(mrow + 32 + 8 * g);
#pragma unroll
            for (int e = 0; e < 4; ++e) { a0[4 * g + e] *= m0[e]; a1[4 * g + e] *= m1[e]; } }
#pragma unroll
        for (int i = 0; i < 16; ++i) o[i] *= qdec;
        { const bf16x8 p00 = pack8(a0, 0), p01 = pack8(a0, 1), p10 = pack8(a1, 0), p11 = pack8(a1, 1);
          bf16x8 vf[4]; lds_tr4<16 * RPT, 8 * RPT>(vf, lds_addr(vperm));
          o = MFMA32(vf[0], p00, o); o = MFMA32(vf[1], p01, o); o = MFMA32(vf[2], p10, o); o = MFMA32(vf[3], p11, o); }
        ret_state_update(accS, lds, wid, lane, cd);
        { const bf16_t* gp = proj + ((size_t)b * SEQ + (n + (c < 7 ? 1 : 0)) * 64 + gt_t) * INW + 3584 + h * 128 + gt_c;
          ga = *(const u32x4*)gp; gb = *(const u32x4*)(gp + 64); }
        float ss = 0.f;
#pragma unroll
        for (int i = 0; i < 16; ++i) ss += o[i] * o[i];
        ss += __shfl_xor(ss, 32);
        if (hi == 0) red[dvb * 64 + itok] = ss;
        __syncthreads();
        const float tot = (red[itok] + red[64 + itok]) + (red[128 + itok] + red[192 + itok]);
        const float rstd = __builtin_amdgcn_rsqf(tot * (1.0f / RD) + EPS);
        { LAS unsigned char* op = lds + R_GT + itok * RP + (dvb * 32 + 4 * hi) * 2;
#pragma unroll
          for (int g = 0; g < 4; ++g) { const u32x2 gv = *(LAS const u32x2*)(op + 16 * g); u32x2 w;
              w.x = cvtpk(o[4 * g] * rstd * bf2f((unsigned short)(gv.x & 0xffff)), o[4 * g + 1] * rstd * bf2f((unsigned short)(gv.x >> 16)));
              w.y = cvtpk(o[4 * g + 2] * rstd * bf2f((unsigned short)(gv.y & 0xffff)), o[4 * g + 3] * rstd * bf2f((unsigned short)(gv.y >> 16)));
              *(LAS u32x2*)(op + 16 * g) = w; } }
        __syncthreads();
        { bf16_t* yp = y + ((size_t)b * SEQ + n * 64 + gt_t) * DM + 512 + h * 128 + gt_c;
          *(u32x4*)yp = *(LAS const u32x4*)gtp; *(u32x4*)(yp + 64) = *(LAS const u32x4*)(gtp + 128); }
    }
    __syncthreads();
}

constexpr size_t WS_CTL = 40 * MiB;
constexpr size_t CTL_ZERO_BYTES = 16384;
constexpr int MISC_OFF = 163840 - 256;
#define XB_TMO      128
#define XB_XCNT(j)  (256  + 64 * (j))
#define XB_XSUB(j)  (1280 + 64 * (j))
#define XB_XGEN(j)  (2304 + 64 * (j))
#define XB_TOP      3328
#define XB_TOPGEN   3392
#define XCD_BAR_WORDS 3456
#define XB_SPIN_CAP (1u << 18)

__device__ __forceinline__ unsigned xb_ld(unsigned* p)              { return __hip_atomic_load(p, __ATOMIC_RELAXED, __HIP_MEMORY_SCOPE_AGENT); }
__device__ __forceinline__ unsigned xb_add(unsigned* p, unsigned v) { return __hip_atomic_fetch_add(p, v, __ATOMIC_RELAXED, __HIP_MEMORY_SCOPE_AGENT); }
__device__ __forceinline__ unsigned xb_xcc_id() { return (unsigned)__builtin_amdgcn_s_getreg((3 << 11) | 20) & 0xFu; }
#define XB_SPIN(cond, bar) do { unsigned _sp = 0; while (cond) { __builtin_amdgcn_s_sleep(1); \
    if ((++_sp & 255u) == 0u) { if (xb_ld(&(bar)[XB_TMO])) break; if (_sp > XB_SPIN_CAP) { atomicAdd(&(bar)[XB_TMO], 1u); break; } } } } while (0)

struct XcdBarrier {
    unsigned* bar; unsigned x;
    volatile LAS unsigned* st;
};

__device__ __forceinline__ XcdBarrier xcd_barrier_post(unsigned* bar, volatile LAS unsigned* st) {
    XcdBarrier b; b.bar = bar; b.x = xb_xcc_id(); b.st = st;
    if (threadIdx.x == 0) (void)xb_add(&bar[XB_XCNT(b.x)], 1u);
    return b;
}
__device__ __forceinline__ void xcd_barrier_complete(unsigned* bar, unsigned x, unsigned& nloc, unsigned& nx) {
    const unsigned G = gridDim.x * gridDim.y * gridDim.z;
    unsigned sum, cnt, mine, sp = 0u;
    for (;;) {
        sum = 0u; cnt = 0u; mine = 0u;
#pragma unroll
        for (unsigned j = 0; j < 16; ++j) { const unsigned c = xb_ld(&bar[XB_XCNT(j)]); sum += c; cnt += (c > 0u) ? 1u : 0u; mine = (j == x) ? c : mine; }
        if (sum == G) break;
        __builtin_amdgcn_s_sleep(1);
        if ((++sp & 255u) == 0u) { if (xb_ld(&bar[XB_TMO])) break; if (sp > XB_SPIN_CAP) { atomicAdd(&bar[XB_TMO], 1u); break; } }
    }
    nloc = mine > 0u ? mine : 1u; nx = cnt > 0u ? cnt : 1u;
}

__device__ __forceinline__ void xcd_barrier(const XcdBarrier& b) {
    asm volatile("s_waitcnt vmcnt(0)" ::: "memory");
    __syncthreads();
    if (threadIdx.x == 0) {
        unsigned* bar = b.bar;
        __builtin_amdgcn_s_waitcnt(0);
        unsigned nloc = b.st[0], nx = b.st[1];
        if (nloc == 0u) { xcd_barrier_complete(bar, b.x, nloc, nx); b.st[0] = nloc; b.st[1] = nx; }
        const unsigned old = xb_add(&bar[XB_XSUB(b.x)], 1u);
        const unsigned gen = old / nloc;
        if (old + 1u == (gen + 1u) * nloc) {
            __builtin_amdgcn_fence(__ATOMIC_RELEASE, "agent");
            asm volatile("s_waitcnt vmcnt(0)" ::: "memory");
            const unsigned og = xb_add(&bar[XB_TOP], 1u);
            const unsigned tg = og / nx;
            if (og + 1u == (tg + 1u) * nx) xb_add(&bar[XB_TOPGEN], 1u);
            else XB_SPIN(xb_ld(&bar[XB_TOPGEN]) == tg, bar);
            __builtin_amdgcn_fence(__ATOMIC_ACQUIRE, "agent");
            xb_add(&bar[XB_XGEN(b.x)], 1u);
            asm volatile("s_waitcnt vmcnt(0)" ::: "memory");
        } else {
            XB_SPIN(xb_ld(&bar[XB_XGEN(b.x)]) == gen, bar);
            __builtin_amdgcn_fence(__ATOMIC_ACQUIRE, "agent");
            asm volatile("s_waitcnt vmcnt(0)" ::: "memory");
        }
    }
    __syncthreads();
}


constexpr int N_PHASES = 10;
#ifndef DUP_PHASE
#define DUP_PHASE -1
#endif
#ifdef PROBE_DOUBLE_BARRIER
#define BAR_EXTRA(b) xcd_barrier(b);
#else
#define BAR_EXTRA(b)
#endif
#ifdef PROBE_STAMP
#define STAMP_DECL unsigned long long st_t0_ = (PROBE_STAMP == 0) ? __builtin_amdgcn_s_memrealtime() : 0ull, st_t1_ = 0;
#define STAMP_AT(k) if ((k) + 1 == PROBE_STAMP) { st_t0_ = __builtin_amdgcn_s_memrealtime(); } if ((k) == PROBE_STAMP) { st_t1_ = __builtin_amdgcn_s_memrealtime(); }
#define STAMP_END if (PROBE_STAMP == 9) st_t1_ = __builtin_amdgcn_s_memrealtime(); if (blockIdx.x == 0) { const unsigned long long d_ = (st_t1_ - st_t0_) * 8ull; const unsigned long long s_ = __builtin_amdgcn_s_memrealtime(); while (__builtin_amdgcn_s_memrealtime() - s_ < d_) __builtin_amdgcn_s_sleep(8); }
#else
#define STAMP_DECL
#define STAMP_AT(k)
#define STAMP_END
#endif
#define REPS(code) for (int rep_ = 0; rep_ < ((DUP_PHASE == (code)) ? 2 : 1); ++rep_)
__global__ void __launch_bounds__(NTHREADS, 2) mega(Args a) {
    extern __shared__ __attribute__((aligned(16))) unsigned char lds_raw[];
    LAS unsigned char* lds = (LAS unsigned char*)lds_raw;
    const int G = gridDim.x, bx = blockIdx.x;
#define PHASE_IDS int tid = threadIdx.x; asm volatile("" : "+v"(tid)); const int lane = tid & 63, wid = __builtin_amdgcn_readfirstlane(tid >> 6); const int gw = bx * NWAVES + wid, NGW = G * NWAVES; (void)lane; (void)gw; (void)NGW;
    unsigned char* ws = a.ws;
#define PHASE_PTRS __attribute__((address_space(1))) unsigned char* wsp_g = (__attribute__((address_space(1))) unsigned char*)a.ws; asm volatile("" : "+s"(wsp_g)); unsigned char* wsp = (unsigned char*)wsp_g;     bf16_t* Win_t = (bf16_t*)(wsp + WS_WIN); bf16_t* Wout_t = (bf16_t*)(wsp + WS_WOUT); \
    float* rot = (float*)(wsp + WS_ROT); float* Tws = (float*)(wsp + WS_T); bf16_t* hb = (bf16_t*)(wsp + WS_HB); bf16_t* proj = (bf16_t*)(wsp + WS_PROJ); \
    bf16_t* xb = (bf16_t*)(wsp + WS_XB); float* ssq = (float*)(wsp + WS_SSQ); (void)xb; (void)ssq; \
    (void)Win_t; (void)Wout_t; (void)rot; (void)Tws; (void)hb; (void)proj;
    const int lo = a.ph_lo, hi_ = a.ph_hi;
    STAMP_DECL
    volatile LAS unsigned* MISC = (volatile LAS unsigned*)(lds + MISC_OFF);
    if (threadIdx.x < 32) MISC[threadIdx.x] = 0u;
    __syncthreads();
    if (hi_ - lo > 1) (void)xcd_barrier_post((unsigned*)(ws + WS_CTL), MISC + 8);
#ifdef ONLY_PH
#define IN(k) ((((k) == 0 ? 0 : ((k) == 9 ? 5 : ((k) - 1) % 4 + 1)) == ONLY_PH) && lo <= (k) && (k) < hi_)
#else
#define IN(k) (lo <= (k) && (k) < hi_)
#endif
#define SEAM(k) do { if (IN(k) && IN((k) + 1)) { XcdBarrier bb_; bb_.bar = (unsigned*)(a.ws + WS_CTL); bb_.x = xb_xcc_id(); bb_.st = (volatile LAS unsigned*)(lds + MISC_OFF) + 8; xcd_barrier(bb_); BAR_EXTRA(bb_) } STAMP_AT(k) } while (0)

    if (IN(0)) {
        PHASE_IDS PHASE_PTRS
        REPS(0) {
        { f32x4 va[4][4], vb[4][4];
          const int st = NGW * 4; int m = gw * 4;
          if (m < MTOK) rows_load<4>(va, a.x + (size_t)m * DM, lane);
          while (m < MTOK) {
              if (m + st < MTOK) rows_load<4>(vb, a.x + (size_t)(m + st) * DM, lane);
              rows_finish<4>(va, xb + (size_t)m * DM, ssq + m, lane);
              m += st; if (m >= MTOK) break;
              if (m + st < MTOK) rows_load<4>(va, a.x + (size_t)(m + st) * DM, lane);
              rows_finish<4>(vb, xb + (size_t)m * DM, ssq + m, lane);
              m += st; } }
        LAS float* scr = (LAS float*)(lds + wid * 16384);
        constexpr int I_IN = (DM / 64) * (INW / 32), I_OUT = (DM / 64) * (DM / 32), I_L = I_IN + I_OUT;
        for (int it = gw; it < DEPTH * I_L; it += NGW) {
            const int l = it / I_L, r = it % I_L;
            if (r < I_IN) transpose_item(a.win + (size_t)l * DM * INW, a.ng + (size_t)l * DM, DM, INW, Win_t + (size_t)l * INW * DM, scr, r, lane);
            else transpose_item(a.wout + (size_t)l * DM * DM, nullptr, DM, DM, Wout_t + (size_t)l * DM * DM, scr, r - I_IN, lane);
        }
        for (int idx = bx * NTHREADS + tid; idx < SEQ * 64; idx += G * NTHREADS) { float c, s; rot_entry(a.pos[idx >> 6], idx & 63, c, s); ((unsigned*)rot)[idx] = cvtpk(c, s); }
        for (int m = bx * NTHREADS + tid; m < 2 * MTOK; m += G * NTHREADS) ssq[MTOK + m] = 0.f;
        }
    }
    SEAM(0);
#pragma unroll
    for (int l = 0; l < DEPTH; ++l) {
        const int p0 = 4 * l;
        if (IN(p0 + 1)) {
            PHASE_PTRS
            pg8::Gemm g{xb, Win_t + (size_t)l * INW * DM, MTOK, INW, DM}; pg8::StaticOrder S; S.init(MTOK, INW, G, bx);
            EpiProj E{proj, ssq + (size_t)l * MTOK};
            REPS(l == 0 ? 1 : 100) pg8::gemm_phase<EpiProj, pg8::StaticOrder, PG8_ALIGN, PG8_SP2>(lds, g, S, E);
        }
        SEAM(p0 + 1);
        if (IN(p0 + 2)) {
            PHASE_IDS PHASE_PTRS
            REPS(l == 0 ? 21 : 100) for (int item = bx; item < 256; item += G) ret_r1_item(proj, rot, Tws, lds, item, tid);
            const float* relb = a.relb + (size_t)l * AH * NREL;
            REPS(l == 0 ? 22 : 100) attn_block_units(proj, hb, relb, lds, bx, G, tid);
        }
        SEAM(p0 + 2);
        if (IN(p0 + 3)) {
            PHASE_IDS PHASE_PTRS
            REPS(l == 0 ? 3 : 100) for (int item = bx; item < 256; item += G) ret_r2_item(proj, rot, Tws, hb, lds, item, tid);
        }
        SEAM(p0 + 3);
        if (IN(p0 + 4)) {
            PHASE_PTRS
            pg8::Gemm g{hb, Wout_t + (size_t)l * DM * DM, MTOK, DM, DM}; pg8::StaticOrder S; S.init(MTOK, DM, G, bx);
            EpiRes E{xb, ssq + (size_t)(l + 1) * MTOK};
            pg8::gemm_phase<EpiRes, pg8::StaticOrder, PG8_ALIGN, PG8_SP2>(lds, g, S, E);
        }
        SEAM(p0 + 4);
    }
    if (IN(9)) {
        PHASE_IDS PHASE_PTRS
        { u32x2 va[4][4], vb[4][4]; float qa[4], qb[4]; f32x4 g[4];
#pragma unroll
          for (int j = 0; j < 4; ++j) g[j] = ((const f32x4*)a.fg + lane)[64 * j];
          const float* sq = ssq + (size_t)DEPTH * MTOK; const int st = NGW * 4; int m = gw * 4;
          if (m < MTOK) fin_load(va, qa, xb + (size_t)m * DM, sq + m, lane);
          while (m < MTOK) {
              if (m + st < MTOK) fin_load(vb, qb, xb + (size_t)(m + st) * DM, sq + m + st, lane);
              fin_finish(va, qa, g, a.out + (size_t)m * DM, lane);
              m += st; if (m >= MTOK) break;
              if (m + st < MTOK) fin_load(va, qa, xb + (size_t)(m + st) * DM, sq + m + st, lane);
              fin_finish(vb, qb, g, a.out + (size_t)m * DM, lane);
              m += st; } }
    }
    STAMP_END
#undef IN
#undef SEAM
}

extern "C" void kernel_launch(void* const* d_in, const int* in_sizes, int n_in, void* d_out, int out_size, void* d_ws, size_t ws_size, hipStream_t stream) {
    static int grid = 0;
    if (grid == 0) {
        int dev = 0, cus = 0, per_cu = 0;
        hipGetDevice(&dev);
        hipDeviceGetAttribute(&cus, hipDeviceAttributeMultiprocessorCount, dev);
        if (hipFuncSetAttribute((const void*)mega, hipFuncAttributeMaxDynamicSharedMemorySize, LDS_BYTES) != hipSuccess) fprintf(stderr, "kernel_launch: hipFuncSetAttribute failed\n");
        if (hipOccupancyMaxActiveBlocksPerMultiprocessor(&per_cu, (const void*)mega, NTHREADS, LDS_BYTES) != hipSuccess || per_cu < 1) { fprintf(stderr, "kernel_launch: occupancy query says %d\n", per_cu); per_cu = 1; }
        (void)hipGetLastError();
        grid = cus * per_cu;
        if (ws_size < WS_END) fprintf(stderr, "kernel_launch: workspace too small: %zu < %zu\n", ws_size, (size_t)WS_END);
    }
    Args a{};
    a.x = (const float*)d_in[0]; a.pos = (const int*)d_in[1]; a.ng = (const float*)d_in[2]; a.win = (const float*)d_in[3]; a.wout = (const float*)d_in[4];
    a.relb = (const float*)d_in[5]; a.fg = (const float*)d_in[6]; a.out = (float*)d_out; a.ws = (unsigned char*)d_ws;
#if MK_MULTI
    for (int ph = 0; ph < N_PHASES; ++ph) { a.ph_lo = ph; a.ph_hi = ph + 1; hipLaunchKernelGGL(mega, dim3(grid), dim3(NTHREADS), LDS_BYTES, stream, a); }
#else
    a.ph_lo = 0; a.ph_hi = N_PHASES;
    if (hipMemsetAsync((char*)d_ws + WS_CTL, 0, CTL_ZERO_BYTES, stream) != hipSuccess) { fprintf(stderr, "kernel_launch: memset failed\n"); return; }
    hipLaunchKernelGGL(mega, dim3(grid), dim3(NTHREADS), LDS_BYTES, stream, a);
#ifdef PROBE_EXTRA_PHASE
    a.out = (float*)((char*)d_ws + 384 * MiB); a.ph_lo = PROBE_EXTRA_PHASE; a.ph_hi = PROBE_EXTRA_PHASE + 1; hipLaunchKernelGGL(mega, dim3(grid), dim3(NTHREADS), LDS_BYTES, stream, a);
#endif
#endif
}
```

```cpp
#include <hip/hip_runtime.h>
#include <hip/hip_cooperative_groups.h>
#include <cstdio>
#include <cstdint>
namespace cg = cooperative_groups;
namespace pg8 {
#define PG8_LAS __attribute__((address_space(3)))
typedef unsigned short bf16_t;
typedef short bf16x8 __attribute__((ext_vector_type(8)));
typedef float f32x4 __attribute__((ext_vector_type(4)));
typedef unsigned u32x4 __attribute__((ext_vector_type(4)));
constexpr int BM = 256, BK = 64, HALF = 128, HTB = HALF * BK * 2  , STAGE_BYTES = 8 * HTB, NXCD = 8, WGM = 8;

__host__ __device__ __forceinline__ int lds_byte(int r, int c) { const int st = (r >> 4) * 2 + (c >> 5), rr = r & 15, cc = c & 31, ob = rr * 64 + cc * 2; return st * 1024 + (ob ^ (((ob >> 9) & 1) << 5)); }
__host__ __device__ __forceinline__ void stage_rc(int b, int& R, int& C) { const int st = b / 1024, sb = b % 1024, swz = sb ^ (((sb >> 9) & 1) << 5); R = (st >> 1) * 16 + swz / 64; C = (st & 1) * 32 + (swz % 64) / 2; }
__host__ __device__ __forceinline__ int perm32(int rho) { const int n = rho >> 4, i = rho & 15; return 8 * (i >> 2) + 4 * n + (i & 3); }

struct Unit { int pm, pn; };
struct Gemm { const bf16_t* A; const bf16_t* Bt; int M, N, K; };

struct StaticOrder {
    int nM, nN, nwg, G, c;
    __host__ __device__ void init(int M, int N, int G_, int c_) { nM = M / BM; nN = N / BM; nwg = nM * nN; G = G_; c = c_; }
    __host__ __device__ bool next(int i, Unit& u) const {
        const long L = (long)i * G + c; if (L >= nwg) return false;
        int wgid = (int)L; { const int q = nwg / NXCD, r = nwg % NXCD, xcd = wgid % NXCD, off = wgid / NXCD; wgid = (xcd < r ? xcd * (q + 1) : r * (q + 1) + (xcd - r) * q) + off; }
        const int nig = WGM * nN, gid = wgid / nig, fm = gid * WGM, gsz = (nM - fm) < WGM ? (nM - fm) : WGM;
        u.pm = fm + ((wgid % nig) % gsz); u.pn = (wgid % nig) / gsz; return true;
    }
    __device__ __forceinline__ void a_ready(const Unit&) const {}
    __device__ __forceinline__ void done(const Unit&) const {}
};

__device__ __forceinline__ unsigned cvt_pk_bf16(float lo, float hi) { unsigned r; asm volatile("v_cvt_pk_bf16_f32 %0, %1, %2" : "=v"(r) : "v"(lo), "v"(hi)); return r; }
typedef float f32x2 __attribute__((ext_vector_type(2)));
__device__ __forceinline__ f32x2 gelu_pk(f32x2 v) {
    const f32x2 av = __builtin_elementwise_abs(v), d = av * 0.2316418882f + 1.0f;
    f32x2 t; t.x = __builtin_amdgcn_rcpf(d.x); t.y = __builtin_amdgcn_rcpf(d.y);
    f32x2 q = t * 0.5307027145f + (-0.7265760135f); q = q * t + 0.7107068705f; q = q * t + (-0.142248368f); q = q * t + 0.127414796f; q = q * t;
    const f32x2 s = (v * v) * (-0.72134752044f);
    f32x2 e; e.x = __builtin_amdgcn_exp2f(s.x); e.y = __builtin_amdgcn_exp2f(s.y);
    const f32x2 m = v * (q * e), r = v - m;
    f32x2 o; o.x = v.x < 0.f ? m.x : r.x; o.y = v.y < 0.f ? m.y : r.y; return o;
}

template <int ACT  > struct EpiBf16 {
    static constexpr bool PERM = true, AFTER_DRAIN = false; static_assert(ACT == 0 || ACT == 1, "EpiBf16: ACT is 0 (none) or 1 (gelu_pk)");
    bf16_t* O; int ldc; const float* bias; int split_cols; size_t split_stride; float scale0;
    __device__ __forceinline__ void operator()(const f32x4 (&acc)[2][2][4][2], const Unit& u, int wr, int wc, int fr, int fq) const {
        const int row0 = u.pm * BM + wr * 64 + fr; int colt = u.pn * BM; bf16_t* base = O;
        float sc = 1.f; if (split_cols) { const int t = colt / split_cols; base += (size_t)t * split_stride; colt -= t * split_cols; if (t == 0) sc = scale0; }
        const int col0 = colt + wc * 32 + 8 * fq, bcol0 = u.pn * BM + wc * 32 + 8 * fq;
        f32x4 bv[2][2];
#pragma unroll
        for (int bj = 0; bj < 2; ++bj)
#pragma unroll
            for (int n = 0; n < 2; ++n) bv[bj][n] = bias ? *(const f32x4*)(bias + bcol0 + bj * HALF + 4 * n) : (f32x4){0.f, 0.f, 0.f, 0.f};
#pragma unroll
        for (int ai = 0; ai < 2; ++ai)
#pragma unroll
            for (int m = 0; m < 4; ++m) { bf16_t* rowp = base + (size_t)(row0 + ai * HALF + m * 16) * ldc + col0;
#pragma unroll
                for (int bj = 0; bj < 2; ++bj) { f32x4 v0 = acc[ai][bj][m][0] + bv[bj][0], v1 = acc[ai][bj][m][1] + bv[bj][1];
                    if (ACT == 1) { f32x2 a = gelu_pk((f32x2){v0[0], v0[1]}), b = gelu_pk((f32x2){v0[2], v0[3]}), c = gelu_pk((f32x2){v1[0], v1[1]}), d = gelu_pk((f32x2){v1[2], v1[3]});
                        v0 = (f32x4){a.x, a.y, b.x, b.y}; v1 = (f32x4){c.x, c.y, d.x, d.y}; }
                    v0 = v0 * sc; v1 = v1 * sc; u32x4 w; w.x = cvt_pk_bf16(v0[0], v0[1]); w.y = cvt_pk_bf16(v0[2], v0[3]); w.z = cvt_pk_bf16(v1[0], v1[1]); w.w = cvt_pk_bf16(v1[2], v1[3]);
                    *(u32x4*)(rowp + bj * HALF) = w; } }
    }
};

struct PanelStats {
    unsigned* xbuf;
    unsigned* cnt;
    unsigned* tmo;
    int ntn; float eps;
    unsigned code;
    __device__ __forceinline__ bool run(const f32x4 (&v)[2][2][4][2], const Unit& u, int wr, int wc, int fr, int fq, PG8_LAS unsigned char* lds, int wid, int lane) const {
        typedef float f32x2v __attribute__((ext_vector_type(2)));
        PG8_LAS f32x2v* P = (PG8_LAS f32x2v*)lds;
        PG8_LAS f32x2v* S = (PG8_LAS f32x2v*)(lds + 8192);
        PG8_LAS unsigned* flag = (PG8_LAS unsigned*)(lds + 8192 + 2048);
#pragma unroll
        for (int ai = 0; ai < 2; ++ai)
#pragma unroll
            for (int m = 0; m < 4; ++m) {
                float s = 0.f;
#pragma unroll
                for (int bj = 0; bj < 2; ++bj)
#pragma unroll
                    for (int n = 0; n < 2; ++n) { const f32x4 x = v[ai][bj][m][n]; s += (x[0] + x[1]) + (x[2] + x[3]); }
                s += __shfl_xor(s, 16); s += __shfl_xor(s, 32);
                const float mw = s * (1.0f / 64.0f); float q = 0.f;
#pragma unroll
                for (int bj = 0; bj < 2; ++bj)
#pragma unroll
                    for (int n = 0; n < 2; ++n) { const f32x4 d = v[ai][bj][m][n] - mw; q += (d[0] * d[0] + d[1] * d[1]) + (d[2] * d[2] + d[3] * d[3]); }
                q += __shfl_xor(q, 16); q += __shfl_xor(q, 32);
                if (fq == 0) P[(ai * HALF + wr * 64 + m * 16 + fr) * 4 + wc] = (f32x2v){mw, q};
            }
        asm volatile("s_waitcnt lgkmcnt(0)" ::: "memory"); __builtin_amdgcn_s_barrier(); asm volatile("" ::: "memory");
#if defined(BROKEN_EXCHANGE_NO_WAIT)
#warning BROKEN CONTROL BUILD: the row-statistics exchange does not wait; results are wrong by design
        if (blockIdx.x >= 64) { const long long t0_ = clock64(); while (clock64() - t0_ < 60000) __builtin_amdgcn_s_sleep(8); }
#endif
        const int row = wid * 32 + (lane & 31);
        if (lane < 32) {
            const f32x2v a = P[row * 4 + 0], b = P[row * 4 + 1], c = P[row * 4 + 2], d = P[row * 4 + 3];
            const float mt = (a.x + b.x + c.x + d.x) * 0.25f;
            const float da = a.x - mt, db = b.x - mt, dc = c.x - mt, dd = d.x - mt;
            const float m2 = (a.y + b.y) + (c.y + d.y) + 64.0f * ((da * da + db * db) + (dc * dc + dd * dd));
            unsigned long long* slot = (unsigned long long*)xbuf + ((size_t)(u.pm * BM + row) * 4 + u.pn);
            __hip_atomic_store(slot, ((unsigned long long)__float_as_uint(m2) << 32) | __float_as_uint(mt), __ATOMIC_RELAXED, __HIP_MEMORY_SCOPE_AGENT);
        }
        asm volatile("s_waitcnt vmcnt(0)" ::: "memory");
        if (lane == 0) __hip_atomic_fetch_add(cnt + 64 * u.pm, 1u, __ATOMIC_RELAXED, __HIP_MEMORY_SCOPE_AGENT);
        if (wid == 0) {
            bool dead = false; const unsigned long long t0 = __builtin_amdgcn_s_memrealtime(); const unsigned want = 8u * (unsigned)ntn;
            for (;;) {
#if defined(BROKEN_EXCHANGE_NO_WAIT)
                break;
#endif
                if ((unsigned)__builtin_amdgcn_readfirstlane(__hip_atomic_load(cnt + 64 * u.pm, __ATOMIC_RELAXED, __HIP_MEMORY_SCOPE_AGENT)) >= want) break;
                if (__builtin_amdgcn_s_memrealtime() - t0 > 2000000ull) {
                    if (lane == 0) { unsigned expect = 0u; __hip_atomic_compare_exchange_strong(tmo + 1, &expect, code | (unsigned)(u.pm & 0xff), __ATOMIC_RELAXED, __ATOMIC_RELAXED, __HIP_MEMORY_SCOPE_AGENT);
                                     __hip_atomic_store(tmo, 1u, __ATOMIC_RELAXED, __HIP_MEMORY_SCOPE_AGENT); }
                    dead = true; break; }
                __builtin_amdgcn_s_sleep(2);
            }
            __builtin_amdgcn_fence(__ATOMIC_ACQUIRE, "agent");
            if (lane == 0) flag[0] = dead ? 1u : 0u;
        }
        asm volatile("s_waitcnt vmcnt(0) lgkmcnt(0)" ::: "memory"); __builtin_amdgcn_s_barrier(); asm volatile("" ::: "memory");
        const bool bad = flag[0] != 0u;
        if (lane < 32) {
            const unsigned long long* slot = (const unsigned long long*)xbuf + (size_t)(u.pm * BM + row) * 4; float mt[4], m2[4]; float ms = 0.f;
#pragma unroll
            for (int t = 0; t < 4; ++t) { if (t < ntn) { const unsigned long long w = __hip_atomic_load(slot + t, __ATOMIC_RELAXED, __HIP_MEMORY_SCOPE_AGENT); mt[t] = __uint_as_float((unsigned)w); m2[t] = __uint_as_float((unsigned)(w >> 32)); } else { mt[t] = 0.f; m2[t] = 0.f; } ms += mt[t]; }
            const float mean = ms / (float)ntn; float q = 0.f;
#pragma unroll
            for (int t = 0; t < 4; ++t) if (t < ntn) { const float dm = mt[t] - mean; q += m2[t] + 256.0f * dm * dm; }
            S[row] = (f32x2v){mean, 1.0f / sqrtf(q / (256.0f * (float)ntn) + eps)};
        }
        asm volatile("s_waitcnt lgkmcnt(0)" ::: "memory"); __builtin_amdgcn_s_barrier(); asm volatile("" ::: "memory");
        return bad;
    }
};
struct EpiLnRes {
    static constexpr bool PERM = false, AFTER_DRAIN = true;
    const float* base; float* out; int ldc; const float* bias; PanelStats st; unsigned poison;
    __device__ __forceinline__ void fused(f32x4 (&acc)[2][2][4][2], const Unit& u, int wr, int wc, int fr, int fq, PG8_LAS unsigned char* lds, int wid, int lane) const {
        typedef float f32x2v __attribute__((ext_vector_type(2)));
        const PG8_LAS f32x2v* S = (const PG8_LAS f32x2v*)(lds + 8192);
        const int col0 = u.pn * BM + wc * 32 + 4 * fq;
#pragma unroll
        for (int bj = 0; bj < 2; ++bj)
#pragma unroll
            for (int n = 0; n < 2; ++n) { const f32x4 bv = bias ? *(const f32x4*)(bias + col0 + bj * HALF + n * 16) : (f32x4){0.f, 0.f, 0.f, 0.f};
#pragma unroll
                for (int ai = 0; ai < 2; ++ai)
#pragma unroll
                    for (int m = 0; m < 4; ++m) acc[ai][bj][m][n] += bv; }
        f32x4 pre[4][2][2];
#pragma unroll
        for (int m = 0; m < 4; ++m) { const size_t off = (size_t)(u.pm * BM + wr * 64 + m * 16 + fr) * ldc + col0;
#pragma unroll
            for (int bj = 0; bj < 2; ++bj)
#pragma unroll
                for (int n = 0; n < 2; ++n) pre[m][bj][n] = *(const f32x4*)(base + off + bj * HALF + n * 16); }
        const bool bad = st.run(acc, u, wr, wc, fr, fq, lds, wid, lane) || poison != 0u;
        const float qnan = __builtin_nanf("");
#pragma unroll
        for (int ai = 0; ai < 2; ++ai)
#pragma unroll
            for (int m = 0; m < 4; ++m) { const int r = ai * HALF + wr * 64 + m * 16 + fr; const f32x2v sr = S[r]; const size_t off = (size_t)(u.pm * BM + r) * ldc + col0;
#pragma unroll
                for (int bj = 0; bj < 2; ++bj)
#pragma unroll
                    for (int n = 0; n < 2; ++n) { const f32x4 bs = ai == 0 ? pre[m][bj][n] : *(const f32x4*)(base + off + bj * HALF + n * 16); f32x4 o = bs + (acc[ai][bj][m][n] - sr.x) * sr.y;
                        if (bad) o = (f32x4){qnan, qnan, qnan, qnan}; *(f32x4*)(out + off + bj * HALF + n * 16) = o; }
                if (m & 1) asm volatile("" ::: "memory"); }
    }
};
struct EpiLnResLn {
    static constexpr bool PERM = false, AFTER_DRAIN = true;
    const float* base; float* out; bf16_t* xn; int ldc; const float* bias; PanelStats st1, st2; unsigned poison;
    __device__ __forceinline__ void fused(f32x4 (&acc)[2][2][4][2], const Unit& u, int wr, int wc, int fr, int fq, PG8_LAS unsigned char* lds, int wid, int lane) const {
        typedef float f32x2v __attribute__((ext_vector_type(2))); typedef unsigned u32x2v __attribute__((ext_vector_type(2)));
        const PG8_LAS f32x2v* S = (const PG8_LAS f32x2v*)(lds + 8192);
        const int col0 = u.pn * BM + wc * 32 + 4 * fq;
#pragma unroll
        for (int bj = 0; bj < 2; ++bj)
#pragma unroll
            for (int n = 0; n < 2; ++n) { const f32x4 bv = bias ? *(const f32x4*)(bias + col0 + bj * HALF + n * 16) : (f32x4){0.f, 0.f, 0.f, 0.f};
#pragma unroll
                for (int ai = 0; ai < 2; ++ai)
#pragma unroll
                    for (int m = 0; m < 4; ++m) acc[ai][bj][m][n] += bv; }
        bool bad = st1.run(acc, u, wr, wc, fr, fq, lds, wid, lane) || poison != 0u;
        const float qnan = __builtin_nanf("");
#pragma unroll
        for (int ai = 0; ai < 2; ++ai)
#pragma unroll
            for (int m = 0; m < 4; ++m) { const int r = ai * HALF + wr * 64 + m * 16 + fr; const f32x2v sr = S[r]; const size_t off = (size_t)(u.pm * BM + r) * ldc + col0;
#pragma unroll
                for (int bj = 0; bj < 2; ++bj)
#pragma unroll
                    for (int n = 0; n < 2; ++n) { const f32x4 bs = *(const f32x4*)(base + off + bj * HALF + n * 16); acc[ai][bj][m][n] = bs + (acc[ai][bj][m][n] - sr.x) * sr.y; }
                asm volatile("" : "+v"(acc[ai][0][m][0]), "+v"(acc[ai][0][m][1]), "+v"(acc[ai][1][m][0]), "+v"(acc[ai][1][m][1]));
                if (m & 1) asm volatile("" ::: "memory"); }
        const bool bad1 = bad;
        bad = st2.run(acc, u, wr, wc, fr, fq, lds, wid, lane) || bad;
#pragma unroll
        for (int ai = 0; ai < 2; ++ai)
#pragma unroll
            for (int m = 0; m < 4; ++m) { const int r = ai * HALF + wr * 64 + m * 16 + fr; const f32x2v sr = S[r]; const size_t off = (size_t)(u.pm * BM + r) * ldc + col0;
#pragma unroll
                for (int bj = 0; bj < 2; ++bj)
#pragma unroll
                    for (int n = 0; n < 2; ++n) { const f32x4 x1 = acc[ai][bj][m][n]; *(f32x4*)(out + off + bj * HALF + n * 16) = bad1 ? (f32x4){qnan, qnan, qnan, qnan} : x1;
                        const f32x4 o = (x1 - sr.x) * sr.y; u32x2v w; w.x = cvt_pk_bf16(o[0], o[1]); w.y = cvt_pk_bf16(o[2], o[3]);
                        if (bad) { w.x = 0x7fc07fc0u; w.y = 0x7fc07fc0u; } *(u32x2v*)(xn + off + bj * HALF + n * 16) = w; }
                asm volatile("" ::: "memory"); }
    }
};

template <class Epi, class Sched, bool ALIGN_EPI = false, bool SP2 = false>
__device__ __forceinline__ void gemm_phase(PG8_LAS unsigned char* lds, const Gemm g, const Sched& S, const Epi& E) {
    int tid_o = threadIdx.x; asm volatile("" : "+v"(tid_o));
    const int tid = tid_o, wid = __builtin_amdgcn_readfirstlane(tid >> 6), lane = tid & 63, wr = wid >> 2, wc = wid & 3, fr = lane & 15, fq = lane >> 4;
    const int K = g.K, nt = K / BK;
    unsigned voffA[2], voffB[2];
#pragma unroll
    for (int i = 0; i < 2; ++i) { int R, C; stage_rc(tid * 16 + i * 8192, R, C); const int Rb = Epi::PERM ? ((R & ~31) + perm32(R & 31)) : R;
        voffA[i] = (unsigned)(R * K + C) * 2u; voffB[i] = (unsigned)(Rb * K + C) * 2u; }
    const size_t kstep = (size_t)(BK * 2);
    const size_t hstep = (size_t)HALF * K * 2;
    const size_t tstep = 2 * hstep;
    const unsigned ldsw = (unsigned)wid * 1024u;
    const int aoff = lds_byte(wr * 64 + fr, fq * 8), boff = lds_byte(wc * 32 + fr, fq * 8);
#define PG8_SA(b, h) (((b) * 2 + (h)) * HTB)
#define PG8_SB(b, h) ((4 + (b) * 2 + (h)) * HTB)
#define PG8_STAGE(bufoff, gbase, voff) do { _Pragma("unroll") for (int _i = 0; _i < 2; ++_i) \
        __builtin_amdgcn_global_load_lds((const unsigned*)((const char*)(gbase) + (voff)[_i]), (PG8_LAS unsigned*)(lds + (bufoff) + ldsw + _i * 8192), 16, 0, 0); } while (0)
#define PG8_LDA(dst, b, h) do { _Pragma("unroll") for (int m = 0; m < 4; ++m) _Pragma("unroll") for (int k = 0; k < 2; ++k) dst[m][k] = *(const PG8_LAS bf16x8*)(lds + PG8_SA(b, h) + aoff + m * 2048 + k * 1024); } while (0)
#define PG8_LDB(dst, b, h) do { _Pragma("unroll") for (int n = 0; n < 2; ++n) _Pragma("unroll") for (int k = 0; k < 2; ++k) dst[n][k] = *(const PG8_LAS bf16x8*)(lds + PG8_SB(b, h) + boff + n * 2048 + k * 1024); } while (0)
#define PG8_MMA(ai, bj, At, Bt) do { __builtin_amdgcn_s_setprio(1); _Pragma("unroll") for (int m = 0; m < 4; ++m) _Pragma("unroll") for (int n = 0; n < 2; ++n) _Pragma("unroll") for (int k = 0; k < 2; ++k) \
        acc[ai][bj][m][n] = __builtin_amdgcn_mfma_f32_16x16x32_bf16(Bt[n][k], At[m][k], acc[ai][bj][m][n], 0, 0, 0); __builtin_amdgcn_s_setprio(0); } while (0)
#define PG8_WAIT_V(n) asm volatile("s_waitcnt vmcnt(" #n ")" ::: "memory")
#define PG8_WAIT_L(n) asm volatile("s_waitcnt lgkmcnt(" #n ")" ::: "memory")
#define PG8_BAR __builtin_amdgcn_s_barrier()
#define PG8_SCHED __builtin_amdgcn_sched_barrier(0)
    Unit cur, nxt; int ui = 0;
    if (!S.next(0, cur)) return;
    f32x4 acc[2][2][4][2];
#pragma unroll
    for (int a = 0; a < 2; ++a)
#pragma unroll
        for (int b = 0; b < 2; ++b)
#pragma unroll
            for (int m = 0; m < 4; ++m)
#pragma unroll
                for (int n = 0; n < 2; ++n) acc[a][b][m][n] = (f32x4){0.f, 0.f, 0.f, 0.f};
    bf16x8 At[4][2], B0[2][2], B1[2][2];
    const char* cA = (const char*)g.A + (size_t)cur.pm * tstep; const char* cB = (const char*)g.Bt + (size_t)cur.pn * tstep;
    S.a_ready(cur);
    if constexpr (SP2) {
        PG8_STAGE(PG8_SB(0, 0), cB, voffB); PG8_STAGE(PG8_SB(0, 1), cB + hstep, voffB); PG8_STAGE(PG8_SA(0, 0), cA, voffA); PG8_STAGE(PG8_SA(0, 1), cA + hstep, voffA);
        if (wr == 1) PG8_BAR;
        PG8_WAIT_V(2); PG8_BAR;
        PG8_STAGE(PG8_SB(1, 0), cB + kstep, voffB); PG8_STAGE(PG8_SA(1, 0), cA + kstep, voffA); PG8_STAGE(PG8_SB(1, 1), cB + hstep + kstep, voffB);
        PG8_WAIT_V(6); PG8_BAR;
    } else {
        PG8_STAGE(PG8_SB(0, 0), cB, voffB); PG8_STAGE(PG8_SA(0, 0), cA, voffA); PG8_STAGE(PG8_SB(0, 1), cB + hstep, voffB); PG8_STAGE(PG8_SA(0, 1), cA + hstep, voffA);
        if (wr == 1) PG8_BAR;
        PG8_WAIT_V(4); PG8_BAR;
        PG8_STAGE(PG8_SB(1, 0), cB + kstep, voffB); PG8_STAGE(PG8_SA(1, 0), cA + kstep, voffA); PG8_STAGE(PG8_SB(1, 1), cB + hstep + kstep, voffB);
        PG8_WAIT_V(6); PG8_BAR;
    }
    for (;;) {
        const bool has_next = S.next(ui + 1, nxt);
        const char* nA = has_next ? (const char*)g.A + (size_t)nxt.pm * tstep : cA; const char* nB = has_next ? (const char*)g.Bt + (size_t)nxt.pn * tstep : cB;
        for (int t = 0; t < nt; t += 2) {
            const bool last = (t == nt - 2);
            const char* a1 = cA + (size_t)(t + 1) * kstep;
            const char* a2 = last ? nA : cA + (size_t)(t + 2) * kstep; const char* b2 = last ? nB : cB + (size_t)(t + 2) * kstep;
            const char* a3 = a2 + kstep; const char* b3 = b2 + kstep;
            if (last && has_next) S.a_ready(nxt);
            if constexpr (SP2) {
            PG8_LDB(B0, 0, 0); PG8_LDB(B1, 0, 1); PG8_SCHED; PG8_LDA(At, 0, 0); PG8_STAGE(PG8_SA(1, 1), a1 + hstep, voffA);
            PG8_WAIT_V(8); PG8_WAIT_L(0); PG8_BAR; PG8_MMA(0, 0, At, B0); PG8_MMA(0, 1, At, B1); PG8_BAR; PG8_SCHED;
            PG8_LDA(At, 0, 1); PG8_STAGE(PG8_SB(0, 0), b2, voffB); PG8_STAGE(PG8_SB(0, 1), b2 + hstep, voffB); PG8_STAGE(PG8_SA(0, 0), a2, voffA);
            PG8_WAIT_V(8); PG8_WAIT_L(0); PG8_BAR; PG8_MMA(1, 0, At, B0); PG8_MMA(1, 1, At, B1); PG8_BAR; PG8_SCHED;
            PG8_LDB(B0, 1, 0); PG8_LDB(B1, 1, 1); PG8_SCHED; PG8_LDA(At, 1, 0); PG8_STAGE(PG8_SA(0, 1), a2 + hstep, voffA);
            PG8_WAIT_V(8); PG8_WAIT_L(0); PG8_BAR; PG8_MMA(0, 0, At, B0); PG8_MMA(0, 1, At, B1); PG8_BAR; PG8_SCHED;
            PG8_LDA(At, 1, 1); PG8_STAGE(PG8_SB(1, 0), b3, voffB); PG8_STAGE(PG8_SB(1, 1), b3 + hstep, voffB); PG8_STAGE(PG8_SA(1, 0), a3, voffA);
            PG8_WAIT_V(8); PG8_WAIT_L(0); PG8_BAR; PG8_MMA(1, 0, At, B0); PG8_MMA(1, 1, At, B1); PG8_BAR; PG8_SCHED;
            } else {
            PG8_LDB(B0, 0, 0); PG8_SCHED; PG8_LDA(At, 0, 0); PG8_STAGE(PG8_SA(1, 1), a1 + hstep, voffA);
            PG8_WAIT_L(8); PG8_BAR; PG8_WAIT_L(0); PG8_MMA(0, 0, At, B0); PG8_BAR; PG8_SCHED;
            PG8_LDB(B1, 0, 1); PG8_STAGE(PG8_SB(0, 0), b2, voffB);
            PG8_BAR; PG8_WAIT_L(0); PG8_MMA(0, 1, At, B1); PG8_BAR;
            PG8_LDA(At, 0, 1); PG8_STAGE(PG8_SA(0, 0), a2, voffA);
            PG8_BAR; PG8_WAIT_L(0); PG8_MMA(1, 0, At, B0); PG8_BAR; PG8_SCHED;
            PG8_STAGE(PG8_SB(0, 1), b2 + hstep, voffB);
            PG8_WAIT_V(6); PG8_BAR; PG8_MMA(1, 1, At, B1); PG8_BAR;
            PG8_LDB(B0, 1, 0); PG8_SCHED; PG8_LDA(At, 1, 0); PG8_STAGE(PG8_SA(0, 1), a2 + hstep, voffA);
            PG8_WAIT_L(8); PG8_BAR; PG8_WAIT_L(0); PG8_MMA(0, 0, At, B0); PG8_BAR; PG8_SCHED;
            PG8_LDB(B1, 1, 1); PG8_STAGE(PG8_SB(1, 0), b3, voffB);
            PG8_BAR; PG8_WAIT_L(0); PG8_MMA(0, 1, At, B1); PG8_BAR;
            PG8_LDA(At, 1, 1); PG8_STAGE(PG8_SA(1, 0), a3, voffA);
            PG8_BAR; PG8_WAIT_L(0); PG8_MMA(1, 0, At, B0); PG8_BAR; PG8_SCHED;
            PG8_STAGE(PG8_SB(1, 1), b3 + hstep, voffB);
            PG8_WAIT_V(6); PG8_BAR; PG8_MMA(1, 1, At, B1); PG8_BAR;
            }
        }
        if constexpr (ALIGN_EPI) { if (wr == 0) PG8_BAR; }
        if constexpr (!Epi::AFTER_DRAIN) { E(acc, cur, wr, wc, fr, fq); S.done(cur); }
        if (!has_next) break;
#pragma unroll
        for (int a = 0; a < 2; ++a)
#pragma unroll
            for (int b = 0; b < 2; ++b)
#pragma unroll
                for (int m = 0; m < 4; ++m)
#pragma unroll
                    for (int n = 0; n < 2; ++n) acc[a][b][m][n] = (f32x4){0.f, 0.f, 0.f, 0.f};
        cur = nxt; cA = nA; cB = nB; ++ui;
        if constexpr (ALIGN_EPI) { if (wr == 1) PG8_BAR; }
    }
    PG8_WAIT_V(0);
    if constexpr (!ALIGN_EPI) { if (wr == 0) PG8_BAR; }
    PG8_BAR;
    if constexpr (Epi::AFTER_DRAIN) { E.fused(acc, cur, wr, wc, fr, fq, lds, wid, lane); S.done(cur); }
#undef PG8_SA
#undef PG8_SB
#undef PG8_STAGE
#undef PG8_LDA
#undef PG8_LDB
#undef PG8_MMA
#undef PG8_WAIT_V
#undef PG8_WAIT_L
#undef PG8_BAR
#undef PG8_SCHED
}
}

#ifndef PG8_SP2
#define PG8_SP2 true
#endif
#ifndef PG8_ALIGN
#define PG8_ALIGN true
#endif

#define LAS __attribute__((address_space(3)))
typedef unsigned short bf16_t;
typedef short bf16x8 __attribute__((ext_vector_type(8)));
typedef short s16x4 __attribute__((ext_vector_type(4)));
typedef float f32x4 __attribute__((ext_vector_type(4)));
typedef float f32x16 __attribute__((ext_vector_type(16)));
typedef unsigned u32x4 __attribute__((ext_vector_type(4)));
typedef unsigned u32x2 __attribute__((ext_vector_type(2)));
typedef float f32x2_t __attribute__((ext_vector_type(2)));
typedef __bf16 bf16x2_t __attribute__((ext_vector_type(2)));

#ifndef MK_MULTI
#define MK_MULTI 0
#endif

constexpr int BATCH = 8, SEQ = 4096, DM = 1024, DEPTH = 2, CHUNK = 64, NCH = SEQ / CHUNK, MTOK = BATCH * SEQ, INW = 4096;
constexpr int AH = 8, AD = 64, RH = 4, RD = 128, NREL = 513;
constexpr float EPS = 1e-6f, LOG2E = 1.4426950408889634f;
constexpr int NTHREADS = 512, NWAVES = 8;
constexpr int LDS_BYTES = 163840;

constexpr size_t MiB = 1u << 20;
constexpr size_t WS_WIN = 0;
constexpr size_t WS_WOUT = 16 * MiB;
constexpr size_t WS_ROT = 20 * MiB;
constexpr size_t WS_T = 22 * MiB;
constexpr size_t WS_HB = 64 * MiB;
constexpr size_t WS_PROJ = 128 * MiB;
constexpr size_t WS_XB = 384 * MiB;
constexpr size_t WS_SSQ = 41 * MiB;
constexpr size_t WS_END = 448 * MiB;

struct Args { const float* x; const int* pos; const float* ng; const float* win; const float* wout; const float* relb; const float* fg; float* out; unsigned char* ws; int ph_lo, ph_hi; };

__device__ __forceinline__ float bf2f(unsigned short u) { return __uint_as_float((unsigned)u << 16); }
__device__ __forceinline__ unsigned cvtpk(float lo, float hi) { f32x2_t v = {lo, hi}; bf16x2_t b = __builtin_convertvector(v, bf16x2_t); return __builtin_bit_cast(unsigned, b); }
__device__ __forceinline__ float ex2(float v) { return __builtin_amdgcn_exp2f(v); }
__device__ __forceinline__ float silu_f(float v) { return v * __builtin_amdgcn_rcpf(1.0f + __builtin_amdgcn_exp2f(-1.4426950408889634f * v)); }
#define MFMA32(a, b, c) __builtin_amdgcn_mfma_f32_32x32x16_bf16((a), (b), (c), 0, 0, 0)
__device__ __forceinline__ float max3f(float a, float b, float c) { float r; asm("v_max3_f32 %0, %1, %2, %3" : "=v"(r) : "v"(a), "v"(b), "v"(c)); return r; }
__device__ __forceinline__ int crow(int reg, int h) { return (reg & 3) + 8 * (reg >> 2) + 4 * h; }
__device__ __forceinline__ float wave_sum(float v) {
#pragma unroll
    for (int o = 1; o < 64; o <<= 1) v += __shfl_xor(v, o);
    return v;
}
__device__ __forceinline__ bf16x8 tr_frag(LAS const unsigned char* p, int d2) {
    const s16x4 lo = __builtin_bit_cast(s16x4, __builtin_amdgcn_ds_read_tr16_b64_v4i16((LAS s16x4*)p));
    const s16x4 hi = __builtin_bit_cast(s16x4, __builtin_amdgcn_ds_read_tr16_b64_v4i16((LAS s16x4*)(p + d2)));
    return (bf16x8){lo[0], lo[1], lo[2], lo[3], hi[0], hi[1], hi[2], hi[3]};
}
__device__ __forceinline__ bf16x8 pack8(const f32x16& x, int s) {
    u32x4 p; p.x = cvtpk(x[8 * s], x[8 * s + 1]); p.y = cvtpk(x[8 * s + 2], x[8 * s + 3]); p.z = cvtpk(x[8 * s + 4], x[8 * s + 5]); p.w = cvtpk(x[8 * s + 6], x[8 * s + 7]);
    return __builtin_bit_cast(bf16x8, p);
}

struct EpiProj {
    static constexpr bool PERM = true, AFTER_DRAIN = false;
    bf16_t* O; const float* ssq;
    __device__ __forceinline__ void operator()(const pg8::f32x4 (&acc)[2][2][4][2], const pg8::Unit& u, int wr, int wc, int fr, int fq) const {
        const int row0 = u.pm * 256 + wr * 64 + fr; const int colt = u.pn * 256; const int seg = colt >> 9;
        const int col0 = colt + wc * 32 + 8 * fq;
        const float sc = seg == 0 ? 0.125f * LOG2E : (seg == 5 ? 0.08838834764831845f : 1.0f);
        const bool act = (seg == 3) || (seg == 7);
        float rs[2][4];
#pragma unroll
        for (int ai = 0; ai < 2; ++ai)
#pragma unroll
            for (int m = 0; m < 4; ++m) rs[ai][m] = ssq[row0 + ai * 128 + m * 16];
#pragma unroll
        for (int ai = 0; ai < 2; ++ai)
#pragma unroll
            for (int m = 0; m < 4; ++m) rs[ai][m] = __builtin_amdgcn_rsqf(rs[ai][m] * (1.0f / DM) + EPS) * sc;
#pragma unroll
        for (int ai = 0; ai < 2; ++ai)
#pragma unroll
            for (int m = 0; m < 4; ++m) { bf16_t* rowp = O + (size_t)(row0 + ai * 128 + m * 16) * INW + col0;
#pragma unroll
                for (int bj = 0; bj < 2; ++bj) { pg8::f32x4 v0 = acc[ai][bj][m][0] * rs[ai][m], v1 = acc[ai][bj][m][1] * rs[ai][m];
                    if (act) {
#pragma unroll
                        for (int e = 0; e < 4; ++e) { v0[e] = silu_f(v0[e]); v1[e] = silu_f(v1[e]); } }
                    u32x4 w; w.x = cvtpk(v0[0], v0[1]); w.y = cvtpk(v0[2], v0[3]); w.z = cvtpk(v1[0], v1[1]); w.w = cvtpk(v1[2], v1[3]);
                    *(u32x4*)(rowp + bj * 128) = w; } }
    }
};
struct EpiRes {
    static constexpr bool PERM = true, AFTER_DRAIN = false;
    bf16_t* xb; float* ssq;
    __device__ __forceinline__ void operator()(const pg8::f32x4 (&acc)[2][2][4][2], const pg8::Unit& u, int wr, int wc, int fr, int fq) const {
        const int row0 = u.pm * 256 + wr * 64 + fr; const int col0 = u.pn * 256 + wc * 32 + 8 * fq;
        u32x4 bb[2][4][2];
#pragma unroll
        for (int ai = 0; ai < 2; ++ai)
#pragma unroll
            for (int m = 0; m < 4; ++m)
#pragma unroll
                for (int bj = 0; bj < 2; ++bj) bb[ai][m][bj] = *(const u32x4*)(xb + (size_t)(row0 + ai * 128 + m * 16) * DM + col0 + bj * 128);
#pragma unroll
        for (int ai = 0; ai < 2; ++ai)
#pragma unroll
            for (int m = 0; m < 4; ++m) { const size_t off = (size_t)(row0 + ai * 128 + m * 16) * DM + col0; float q = 0.f;
#pragma unroll
                for (int bj = 0; bj < 2; ++bj) {
                    const u32x4 b = bb[ai][m][bj]; f32x4 o0, o1;
                    o0[0] = __uint_as_float(b.x << 16) + acc[ai][bj][m][0][0]; o0[1] = __uint_as_float(b.x & 0xffff0000u) + acc[ai][bj][m][0][1];
                    o0[2] = __uint_as_float(b.y << 16) + acc[ai][bj][m][0][2]; o0[3] = __uint_as_float(b.y & 0xffff0000u) + acc[ai][bj][m][0][3];
                    o1[0] = __uint_as_float(b.z << 16) + acc[ai][bj][m][1][0]; o1[1] = __uint_as_float(b.z & 0xffff0000u) + acc[ai][bj][m][1][1];
                    o1[2] = __uint_as_float(b.w << 16) + acc[ai][bj][m][1][2]; o1[3] = __uint_as_float(b.w & 0xffff0000u) + acc[ai][bj][m][1][3];
                    u32x4 w; w.x = cvtpk(o0[0], o0[1]); w.y = cvtpk(o0[2], o0[3]); w.z = cvtpk(o1[0], o1[1]); w.w = cvtpk(o1[2], o1[3]);
                    *(u32x4*)(xb + off + bj * 128) = w;
#pragma unroll
                    for (int e = 0; e < 4; ++e) q += o0[e] * o0[e] + o1[e] * o1[e]; }
                q += __shfl_xor(q, 16); q += __shfl_xor(q, 32); if (fq == 0) unsafeAtomicAdd(ssq + row0 + ai * 128 + m * 16, q); }
    }
};

__device__ __forceinline__ void transpose_item(const float* W, const float* gain  , int K, int N, bf16_t* WT, LAS float* scr, int item, int lane) {
    const int nblk = N / 32, kb = item / nblk, nb = item % nblk, k0 = 64 * kb, n0 = 32 * nb;
    { f32x4 v[8]; float g[8];
#pragma unroll
      for (int it = 0; it < 8; ++it) { const int kk = it * 8 + (lane >> 3); v[it] = __builtin_nontemporal_load((const f32x4*)(W + (size_t)(k0 + kk) * N + n0 + (lane & 7) * 4)); g[it] = gain ? gain[k0 + kk] : 1.0f; }
#pragma unroll
      for (int it = 0; it < 8; ++it) { const int kk = it * 8 + (lane >> 3); LAS float* d = scr + kk * 33 + (lane & 7) * 4;
          d[0] = v[it][0] * g[it]; d[1] = v[it][1] * g[it]; d[2] = v[it][2] * g[it]; d[3] = v[it][3] * g[it]; } }
    __builtin_amdgcn_wave_barrier();
    const int c = lane & 7;
#pragma unroll
    for (int j = 0; j < 4; ++j) { const int n = (lane >> 3) + 8 * j; const LAS float* s = scr + (8 * c) * 33 + n;
        u32x4 o; o.x = cvtpk(s[0 * 33], s[1 * 33]); o.y = cvtpk(s[2 * 33], s[3 * 33]); o.z = cvtpk(s[4 * 33], s[5 * 33]); o.w = cvtpk(s[6 * 33], s[7 * 33]);
        *(u32x4*)(WT + (size_t)(n0 + n) * K + k0 + 8 * c) = o; }
    __builtin_amdgcn_wave_barrier();
}
__device__ __forceinline__ void rms_row_bf16(const float* xrow, const float* gain, bf16_t* orow, int lane) {
    const f32x4* xr = (const f32x4*)xrow + lane; const f32x4* gr = (const f32x4*)gain + lane;
    f32x4 v[4]; float s = 0.f;
#pragma unroll
    for (int j = 0; j < 4; ++j) { v[j] = xr[64 * j]; s += (v[j][0] * v[j][0] + v[j][1] * v[j][1]) + (v[j][2] * v[j][2] + v[j][3] * v[j][3]); }
    const float rstd = 1.0f / sqrtf(wave_sum(s) * (1.0f / DM) + EPS);
    u32x2* o8 = (u32x2*)orow + lane;
#pragma unroll
    for (int j = 0; j < 4; ++j) { const f32x4 g = gr[64 * j]; u32x2 w; w.x = cvtpk(v[j][0] * rstd * g[0], v[j][1] * rstd * g[1]); w.y = cvtpk(v[j][2] * rstd * g[2], v[j][3] * rstd * g[3]); o8[64 * j] = w; }
}
template <int NR>
__device__ __forceinline__ void rows_bf16_ssq(const float* xrow, bf16_t* orow, float* ssq, int lane) {
    f32x4 v[NR][4];
#pragma unroll
    for (int rr = 0; rr < NR; ++rr)
#pragma unroll
        for (int j = 0; j < 4; ++j) v[rr][j] = __builtin_nontemporal_load((const f32x4*)(xrow + (size_t)rr * DM) + lane + 64 * j);
#pragma unroll
    for (int rr = 0; rr < NR; ++rr) { float s = 0.f;
#pragma unroll
        for (int j = 0; j < 4; ++j) s += (v[rr][j][0] * v[rr][j][0] + v[rr][j][1] * v[rr][j][1]) + (v[rr][j][2] * v[rr][j][2] + v[rr][j][3] * v[rr][j][3]);
        s = wave_sum(s);
        u32x2* o8 = (u32x2*)(orow + (size_t)rr * DM) + lane;
#pragma unroll
        for (int j = 0; j < 4; ++j) { u32x2 w; w.x = cvtpk(v[rr][j][0], v[rr][j][1]); w.y = cvtpk(v[rr][j][2], v[rr][j][3]); o8[64 * j] = w; }
        if (lane == 0) ssq[rr] = s; }
}
template <int NR>
__device__ __forceinline__ void rows_load(f32x4 (&v)[NR][4], const float* xrow, int lane) {
#pragma unroll
    for (int rr = 0; rr < NR; ++rr)
#pragma unroll
        for (int j = 0; j < 4; ++j) v[rr][j] = __builtin_nontemporal_load((const f32x4*)(xrow + (size_t)rr * DM) + lane + 64 * j);
}
template <int NR>
__device__ __forceinline__ void rows_finish(const f32x4 (&v)[NR][4], bf16_t* orow, float* ssq, int lane) {
#pragma unroll
    for (int rr = 0; rr < NR; ++rr) { float s = 0.f;
#pragma unroll
        for (int j = 0; j < 4; ++j) s += (v[rr][j][0] * v[rr][j][0] + v[rr][j][1] * v[rr][j][1]) + (v[rr][j][2] * v[rr][j][2] + v[rr][j][3] * v[rr][j][3]);
        s = wave_sum(s);
        u32x2* o8 = (u32x2*)(orow + (size_t)rr * DM) + lane;
#pragma unroll
        for (int j = 0; j < 4; ++j) { u32x2 w; w.x = cvtpk(v[rr][j][0], v[rr][j][1]); w.y = cvtpk(v[rr][j][2], v[rr][j][3]); o8[64 * j] = w; }
        if (lane == 0) ssq[rr] = s; }
}
__device__ __forceinline__ void rms_rows4_final(const bf16_t* xrow, const float* ssq, const float* gain, float* orow, int lane) {
    u32x2 v[4][4]; float rstd[4]; f32x4 g[4];
#pragma unroll
    for (int rr = 0; rr < 4; ++rr) { rstd[rr] = ssq[rr];
#pragma unroll
        for (int j = 0; j < 4; ++j) v[rr][j] = __builtin_nontemporal_load((const u32x2*)(xrow + (size_t)rr * DM) + lane + 64 * j); }
#pragma unroll
    for (int j = 0; j < 4; ++j) g[j] = ((const f32x4*)gain + lane)[64 * j];
#pragma unroll
    for (int rr = 0; rr < 4; ++rr) { const float rs = __builtin_amdgcn_rsqf(rstd[rr] * (1.0f / DM) + EPS); f32x4* o = (f32x4*)(orow + (size_t)rr * DM) + lane;
#pragma unroll
        for (int j = 0; j < 4; ++j) { f32x4 w;
            w[0] = __uint_as_float(v[rr][j].x << 16) * rs * g[j][0]; w[1] = __uint_as_float(v[rr][j].x & 0xffff0000u) * rs * g[j][1];
            w[2] = __uint_as_float(v[rr][j].y << 16) * rs * g[j][2]; w[3] = __uint_as_float(v[rr][j].y & 0xffff0000u) * rs * g[j][3]; __builtin_nontemporal_store(w, o + 64 * j); } }
}
__device__ __forceinline__ void rms_row_f32(const float* xrow, const float* gain, float* orow, int lane) {
    const f32x4* xr = (const f32x4*)xrow + lane; const f32x4* gr = (const f32x4*)gain + lane;
    f32x4 v[4]; float s = 0.f;
#pragma unroll
    for (int j = 0; j < 4; ++j) { v[j] = xr[64 * j]; s += (v[j][0] * v[j][0] + v[j][1] * v[j][1]) + (v[j][2] * v[j][2] + v[j][3] * v[j][3]); }
    const float rstd = 1.0f / sqrtf(wave_sum(s) * (1.0f / DM) + EPS);
    f32x4* o = (f32x4*)orow + lane;
#pragma unroll
    for (int j = 0; j < 4; ++j) { const f32x4 g = gr[64 * j]; f32x4 w; w[0] = v[j][0] * rstd * g[0]; w[1] = v[j][1] * rstd * g[1]; w[2] = v[j][2] * rstd * g[2]; w[3] = v[j][3] * rstd * g[3]; o[64 * j] = w; }
}
__device__ __forceinline__ void rot_entry(int pos, int j, float& c, float& s) {
    const float invf = (float)exp2(-(double)j * (13.287712379549449 / 63.0));
    const float ang = (float)pos * invf;
    const double x = (double)ang;
    const double k = rint(x * 0.15915494309189535);
    const double r = x - k * 6.283185307179586;
    const double r2 = r * r; double sp = 1.0, cp = 1.0;
#pragma unroll
    for (int n = 16; n >= 1; --n) { sp = 1.0 - sp * r2 * (1.0 / (double)((2 * n) * (2 * n + 1))); cp = 1.0 - cp * r2 * (1.0 / (double)((2 * n - 1) * (2 * n))); }
    s = (float)(r * sp); c = (float)cp;
}


__device__ __forceinline__ void lds_read_k8(bf16x8 (&kf)[8], unsigned addr) {
    asm volatile("ds_read_b128 %0, %8\n\tds_read_b128 %1, %8 offset:4608\n\tds_read_b128 %2, %8 offset:32\n\tds_read_b128 %3, %8 offset:4640\n\t"
                 "ds_read_b128 %4, %8 offset:64\n\tds_read_b128 %5, %8 offset:4672\n\tds_read_b128 %6, %8 offset:96\n\tds_read_b128 %7, %8 offset:4704\n\ts_waitcnt lgkmcnt(0)"
                 : "=&v"(kf[0]), "=&v"(kf[1]), "=&v"(kf[2]), "=&v"(kf[3]), "=&v"(kf[4]), "=&v"(kf[5]), "=&v"(kf[6]), "=&v"(kf[7]) : "v"(addr) : "memory");
}
__device__ __forceinline__ void lds_read_v8(bf16x8 (&vf)[8], unsigned addr) {
    s16x4 a0, a1, a2, a3, a4, a5, a6, a7, b0, b1, b2, b3, b4, b5, b6, b7;
    asm volatile("ds_read_b64_tr_b16 %0, %16\n\tds_read_b64_tr_b16 %8, %16 offset:1536\n\t"
                 "ds_read_b64_tr_b16 %1, %16 offset:64\n\tds_read_b64_tr_b16 %9, %16 offset:1600\n\t"
                 "ds_read_b64_tr_b16 %2, %16 offset:3072\n\tds_read_b64_tr_b16 %10, %16 offset:4608\n\t"
                 "ds_read_b64_tr_b16 %3, %16 offset:3136\n\tds_read_b64_tr_b16 %11, %16 offset:4672\n\t"
                 "ds_read_b64_tr_b16 %4, %16 offset:6144\n\tds_read_b64_tr_b16 %12, %16 offset:7680\n\t"
                 "ds_read_b64_tr_b16 %5, %16 offset:6208\n\tds_read_b64_tr_b16 %13, %16 offset:7744\n\t"
                 "ds_read_b64_tr_b16 %6, %16 offset:9216\n\tds_read_b64_tr_b16 %14, %16 offset:10752\n\t"
                 "ds_read_b64_tr_b16 %7, %16 offset:9280\n\tds_read_b64_tr_b16 %15, %16 offset:10816\n\ts_waitcnt lgkmcnt(0)"
                 : "=&v"(a0), "=&v"(a1), "=&v"(a2), "=&v"(a3), "=&v"(a4), "=&v"(a5), "=&v"(a6), "=&v"(a7),
                   "=&v"(b0), "=&v"(b1), "=&v"(b2), "=&v"(b3), "=&v"(b4), "=&v"(b5), "=&v"(b6), "=&v"(b7) : "v"(addr) : "memory");
#define CAT_(lo, hi) __builtin_shufflevector(lo, hi, 0, 1, 2, 3, 4, 5, 6, 7)
    vf[0] = CAT_(a0, b0); vf[1] = CAT_(a1, b1); vf[2] = CAT_(a2, b2); vf[3] = CAT_(a3, b3); vf[4] = CAT_(a4, b4); vf[5] = CAT_(a5, b5); vf[6] = CAT_(a6, b6); vf[7] = CAT_(a7, b7);
#undef CAT_
}
__device__ __forceinline__ void lds_read_v8_nowait(bf16x8 (&vf)[8], unsigned addr) {
    s16x4 a0, a1, a2, a3, a4, a5, a6, a7, b0, b1, b2, b3, b4, b5, b6, b7;
    asm volatile("ds_read_b64_tr_b16 %0, %16\n\tds_read_b64_tr_b16 %8, %16 offset:1536\n\t"
                 "ds_read_b64_tr_b16 %1, %16 offset:64\n\tds_read_b64_tr_b16 %9, %16 offset:1600\n\t"
                 "ds_read_b64_tr_b16 %2, %16 offset:3072\n\tds_read_b64_tr_b16 %10, %16 offset:4608\n\t"
                 "ds_read_b64_tr_b16 %3, %16 offset:3136\n\tds_read_b64_tr_b16 %11, %16 offset:4672\n\t"
                 "ds_read_b64_tr_b16 %4, %16 offset:6144\n\tds_read_b64_tr_b16 %12, %16 offset:7680\n\t"
                 "ds_read_b64_tr_b16 %5, %16 offset:6208\n\tds_read_b64_tr_b16 %13, %16 offset:7744\n\t"
                 "ds_read_b64_tr_b16 %6, %16 offset:9216\n\tds_read_b64_tr_b16 %14, %16 offset:10752\n\t"
                 "ds_read_b64_tr_b16 %7, %16 offset:9280\n\tds_read_b64_tr_b16 %15, %16 offset:10816"
                 : "=&v"(a0), "=&v"(a1), "=&v"(a2), "=&v"(a3), "=&v"(a4), "=&v"(a5), "=&v"(a6), "=&v"(a7),
                   "=&v"(b0), "=&v"(b1), "=&v"(b2), "=&v"(b3), "=&v"(b4), "=&v"(b5), "=&v"(b6), "=&v"(b7) : "v"(addr) : "memory");
#define CAT_(lo, hi) __builtin_shufflevector(lo, hi, 0, 1, 2, 3, 4, 5, 6, 7)
    vf[0] = CAT_(a0, b0); vf[1] = CAT_(a1, b1); vf[2] = CAT_(a2, b2); vf[3] = CAT_(a3, b3); vf[4] = CAT_(a4, b4); vf[5] = CAT_(a5, b5); vf[6] = CAT_(a6, b6); vf[7] = CAT_(a7, b7);
#undef CAT_
}
__device__ __forceinline__ void lds_wait8(bf16x8 (&vf)[8]) {
    asm volatile("s_waitcnt lgkmcnt(0)" : "+v"(vf[0]), "+v"(vf[1]), "+v"(vf[2]), "+v"(vf[3]), "+v"(vf[4]), "+v"(vf[5]), "+v"(vf[6]), "+v"(vf[7]) : : "memory");
}
__device__ __forceinline__ unsigned lds_addr(LAS const unsigned char* p) { return (unsigned)(uintptr_t)p; }
constexpr int PK = 144, PV = 192;
constexpr int ATT_BUF = 64 * PK + 64 * PV;
constexpr int ATT_NBUF = 2;
constexpr int ATT_BIAS = ATT_NBUF * ATT_BUF;
constexpr int BT_STRIDE = 656;
constexpr int ATT_END = ATT_BIAS + 4 * BT_STRIDE * 4;
constexpr int ATT_OST = ATT_END;
static_assert(ATT_OST + 8 * 32 * 144 <= 131072, "attention LDS");
__device__ __forceinline__ void attn_block_units(const bf16_t* __restrict__ proj, bf16_t* __restrict__ y, const float* __restrict__ relb, LAS unsigned char* lds, int bx, int G, int tid) {
    const int lane = tid & 63, wid = __builtin_amdgcn_readfirstlane(tid >> 6), r = lane & 31, hi = lane >> 5;
    const int ci = wid >> 1, qh = wid & 1;
    LAS float* biasT = (LAS float*)(lds + ATT_BIAS);
    const int srow = tid >> 3, scc = tid & 7;
    LAS unsigned char* stk = lds + srow * PK + scc * 16; LAS unsigned char* stv = lds + 64 * PK + srow * PV + scc * 16;
    const int qi = qh * 32 + r;
    const int i16 = lane & 15, tq_ = i16 >> 2, tp = i16 & 3, blk = (lane >> 4) & 1;
    LAS const unsigned char* kbase = lds + r * PK + 16 * hi;
    LAS const unsigned char* vperm = lds + 64 * PK + (4 * hi + tq_) * PV + (16 * blk + 4 * tp) * 2;
    const int xb = 63 - qi + 4 * hi;
    LAS const float* bbase = biasT + (xb & 3) * BT_STRIDE + (xb & ~3);
    if (bx >= 1024) return;
#define ATT_UNIT(u, b_, h_, n0_) const int b_ = (u) & 7, h_ = ((u) >> 3) & 7, n0_ = ((u) >> 6) * 4
    int u = bx; int hprev = -1;
    bf16x8 qf[4]; u32x4 kreg, vreg;
    { ATT_UNIT(u, b, h, n0); const int c0 = n0 >= 8 ? 0 : 8 - n0;
      const bf16_t* qp = proj + ((size_t)b * SEQ + (n0 + ci) * 64 + qh * 32 + r) * INW + h * 64 + 8 * hi;
#pragma unroll
      for (int s = 0; s < 4; ++s) qf[s] = *(const bf16x8*)(qp + 16 * s);
      const bf16_t* gk = proj + ((size_t)b * SEQ + (size_t)(n0 - 8 + c0) * 64 + srow) * INW + 512 + h * 64 + scc * 8;
      kreg = *(const u32x4*)gk; vreg = *(const u32x4*)(gk + 512); }
#pragma unroll 1
    for (; u < 1024; u += G) {
        ATT_UNIT(u, b, h, n0); const int n = n0 + ci;
        if (h != hprev) { hprev = h;
            for (int e = tid; e < 4 * BT_STRIDE; e += NTHREADS) { const int sh = e / BT_STRIDE, x = e - sh * BT_STRIDE + sh; const int dist = 575 - x; int idx = (dist < 256 ? dist : 256) + 256; idx = idx < 0 ? 0 : idx;
                biasT[e] = relb[h * NREL + idx] * LOG2E; } }
        const size_t tq = (size_t)b * SEQ + n * 64 + qh * 32;
        const int c0 = n0 >= 8 ? 0 : 8 - n0;
        const bf16_t* gk = proj + ((size_t)b * SEQ + (size_t)(n0 - 8 + c0) * 64 + srow) * INW + 512 + h * 64 + scc * 8;
        *(LAS u32x4*)stk = kreg; *(LAS u32x4*)stv = vreg;
        u32x4 kreg2, vreg2;
        { gk += (size_t)64 * INW; kreg = *(const u32x4*)gk; vreg = *(const u32x4*)(gk + 512); kreg2 = kreg; vreg2 = vreg; }
        __syncthreads();
        f32x16 o0, o1;
#pragma unroll
        for (int i = 0; i < 16; ++i) { o0[i] = 0.f; o1[i] = 0.f; }
        float m = -1e30f, l = 0.f;
        u32x4 gq[4];
        bf16x8 qn[4];
#pragma unroll
        for (int i = 0; i < 4; ++i) { gq[i] = (u32x4){0u, 0u, 0u, 0u}; qn[i] = qf[i]; }
        const bf16_t* gp = proj + (tq + (lane >> 3)) * INW + 1536 + h * 64 + (lane & 7) * 8;
        const bool has_next = (u + G) < 1024;
#pragma unroll 1
        for (int c = c0; c < 12; ++c) {
            const int boff = ((c - c0) & 1) * ATT_BUF;
            if (c < 10) { gk += (size_t)64 * INW; kreg2 = *(const u32x4*)gk; vreg2 = *(const u32x4*)(gk + 512); }
            if (c == 11) {
#pragma unroll
                for (int it = 0; it < 4; ++it) gq[it] = *(const u32x4*)(gp + (size_t)it * 8 * INW);
                if (has_next) { ATT_UNIT(u + G, b2, h2, n02); const int c02 = n02 >= 8 ? 0 : 8 - n02;
                    const bf16_t* qp = proj + ((size_t)b2 * SEQ + (n02 + ci) * 64 + qh * 32 + r) * INW + h2 * 64 + 8 * hi;
#pragma unroll
                    for (int s = 0; s < 4; ++s) qn[s] = *(const bf16x8*)(qp + 16 * s);
                    const bf16_t* gk2 = proj + ((size_t)b2 * SEQ + (size_t)(n02 - 8 + c02) * 64 + srow) * INW + 512 + h2 * 64 + scc * 8;
                    kreg = *(const u32x4*)gk2; vreg = *(const u32x4*)(gk2 + 512); } }
            const int j = c - ci;
            if (j >= 0 && j < 9) {
                f32x16 s0, s1;
                { LAS const float* bp = bbase + j * 64;
#pragma unroll
                  for (int g = 0; g < 4; ++g) { const f32x4 b0 = *(LAS const f32x4*)(bp + 8 * g), b1 = *(LAS const f32x4*)(bp + 32 + 8 * g);
#pragma unroll
                      for (int e = 0; e < 4; ++e) { s0[4 * g + e] = b0[e]; s1[4 * g + e] = b1[e]; } } }
                { bf16x8 kf[8]; lds_read_k8(kf, lds_addr(kbase + boff));
#pragma unroll
                  for (int s = 0; s < 4; ++s) { s0 = MFMA32(kf[2 * s], qf[s], s0); s1 = MFMA32(kf[2 * s + 1], qf[s], s1); } }
                bf16x8 vf[8]; lds_read_v8_nowait(vf, lds_addr(vperm + boff));
                { float mx = fmaxf(s0[0], s1[0]), mx2 = fmaxf(s0[1], s1[1]);
#pragma unroll
                  for (int reg = 2; reg < 16; reg += 2) { mx = max3f(mx, s0[reg], s1[reg]); mx2 = max3f(mx2, s0[reg + 1], s1[reg + 1]); }
                  mx = fmaxf(mx, mx2);
                  mx = fmaxf(mx, __shfl_xor(mx, 32));
                  const bool grow = (mx - m) > 8.0f;
                  if (__any(grow)) { const float mnew = grow ? mx : m, alpha = ex2(m - mnew); m = mnew; l *= alpha;
#pragma unroll
                      for (int reg = 0; reg < 16; ++reg) { o0[reg] *= alpha; o1[reg] *= alpha; } }
                  float ls0 = 0.f, ls1 = 0.f;
#pragma unroll
                  for (int reg = 0; reg < 16; ++reg) { s0[reg] = ex2(s0[reg] - m); s1[reg] = ex2(s1[reg] - m); ls0 += s0[reg]; ls1 += s1[reg]; }
                  l += ls0 + ls1; }
                { const bf16x8 p00 = pack8(s0, 0), p01 = pack8(s0, 1), p10 = pack8(s1, 0), p11 = pack8(s1, 1);
                  lds_wait8(vf);
                  o0 = MFMA32(vf[0], p00, o0); o1 = MFMA32(vf[1], p00, o1);
                  o0 = MFMA32(vf[2], p01, o0); o1 = MFMA32(vf[3], p01, o1);
                  o0 = MFMA32(vf[4], p10, o0); o1 = MFMA32(vf[5], p10, o1);
                  o0 = MFMA32(vf[6], p11, o0); o1 = MFMA32(vf[7], p11, o1); }
            }
            if (c < 11) { const int woff = (((c - c0) & 1) ^ 1) * ATT_BUF; *(LAS u32x4*)(stk + woff) = kreg; *(LAS u32x4*)(stv + woff) = vreg; kreg = kreg2; vreg = vreg2; }
            __syncthreads();
        }
        l += __shfl_xor(l, 32);
        const float inv = __builtin_amdgcn_rcpf(l);
        { LAS unsigned char* ot = lds + ATT_OST + wid * (32 * 144);
          __builtin_amdgcn_wave_barrier();
#pragma unroll
          for (int it = 0; it < 4; ++it) *(LAS u32x4*)(ot + (it * 8 + (lane >> 3)) * 144 + (lane & 7) * 16) = gq[it];
          __builtin_amdgcn_wave_barrier();
          LAS unsigned char* orow = ot + r * 144 + 8 * hi;
#pragma unroll
          for (int g = 0; g < 4; ++g) {
              const u32x2 g0 = *(LAS const u32x2*)(orow + 16 * g), g1 = *(LAS const u32x2*)(orow + 64 + 16 * g);
              u32x2 w0, w1;
              w0.x = cvtpk(o0[4 * g] * inv * bf2f((unsigned short)(g0.x & 0xffff)), o0[4 * g + 1] * inv * bf2f((unsigned short)(g0.x >> 16)));
              w0.y = cvtpk(o0[4 * g + 2] * inv * bf2f((unsigned short)(g0.y & 0xffff)), o0[4 * g + 3] * inv * bf2f((unsigned short)(g0.y >> 16)));
              w1.x = cvtpk(o1[4 * g] * inv * bf2f((unsigned short)(g1.x & 0xffff)), o1[4 * g + 1] * inv * bf2f((unsigned short)(g1.x >> 16)));
              w1.y = cvtpk(o1[4 * g + 2] * inv * bf2f((unsigned short)(g1.y & 0xffff)), o1[4 * g + 3] * inv * bf2f((unsigned short)(g1.y >> 16)));
              *(LAS u32x2*)(orow + 16 * g) = w0; *(LAS u32x2*)(orow + 64 + 16 * g) = w1;
          }
          __builtin_amdgcn_wave_barrier();
          bf16_t* yp = y + (tq + (lane >> 3)) * DM + h * 64 + (lane & 7) * 8;
#pragma unroll
          for (int it = 0; it < 4; ++it) *(u32x4*)(yp + (size_t)it * 8 * DM) = *(LAS const u32x4*)(ot + (it * 8 + (lane >> 3)) * 144 + (lane & 7) * 16);
          __builtin_amdgcn_wave_barrier(); }
#pragma unroll
        for (int i = 0; i < 4; ++i) qf[i] = qn[i];
    }
#undef ATT_UNIT
}

constexpr int RP = 272;
constexpr int RPT = 320;
constexpr int R_QS = 0, R_KS = 64 * RP, R_KD = 2 * 64 * RP, R_VS = R_KD + 64 * RPT, R_ST = R_VS + 64 * RPT, R_RED = R_ST + 128 * RP, R_END = R_RED + 4 * 64 * 4;
static_assert(R_END <= 163840 - 512, "retention LDS");
__device__ __forceinline__ float log2gamma(int h) { return log2f(1.0f - ex2(-5.0f - (float)h)); }

__device__ __forceinline__ void unpack8(const u32x4 v, float (&f)[8]) {
    f[0] = __uint_as_float(v.x << 16); f[1] = __uint_as_float(v.x & 0xffff0000u); f[2] = __uint_as_float(v.y << 16); f[3] = __uint_as_float(v.y & 0xffff0000u);
    f[4] = __uint_as_float(v.z << 16); f[5] = __uint_as_float(v.z & 0xffff0000u); f[6] = __uint_as_float(v.w << 16); f[7] = __uint_as_float(v.w & 0xffff0000u);
}
__device__ __forceinline__ u32x4 packf8(const float (&f)[8]) { u32x4 w; w.x = cvtpk(f[0], f[1]); w.y = cvtpk(f[2], f[3]); w.z = cvtpk(f[4], f[5]); w.w = cvtpk(f[6], f[7]); return w; }

#define RD8_OUT(f) "=&v"(f[0]), "=&v"(f[1]), "=&v"(f[2]), "=&v"(f[3]), "=&v"(f[4]), "=&v"(f[5]), "=&v"(f[6]), "=&v"(f[7])
__device__ __forceinline__ void lds_rd8(bf16x8 (&f)[8], unsigned addr) {
    asm volatile("ds_read_b128 %0, %8\n\tds_read_b128 %1, %8 offset:32\n\tds_read_b128 %2, %8 offset:64\n\tds_read_b128 %3, %8 offset:96\n\t"
                 "ds_read_b128 %4, %8 offset:128\n\tds_read_b128 %5, %8 offset:160\n\tds_read_b128 %6, %8 offset:192\n\tds_read_b128 %7, %8 offset:224\n\ts_waitcnt lgkmcnt(0)"
                 : RD8_OUT(f) : "v"(addr) : "memory");
}
__device__ __forceinline__ void lds_rd16(bf16x8 (&f)[8], bf16x8 (&g)[8], unsigned a0, unsigned a1) {
    asm volatile("ds_read_b128 %0, %16\n\tds_read_b128 %1, %16 offset:32\n\tds_read_b128 %2, %16 offset:64\n\tds_read_b128 %3, %16 offset:96\n\t"
                 "ds_read_b128 %4, %16 offset:128\n\tds_read_b128 %5, %16 offset:160\n\tds_read_b128 %6, %16 offset:192\n\tds_read_b128 %7, %16 offset:224\n\t"
                 "ds_read_b128 %8, %17\n\tds_read_b128 %9, %17 offset:32\n\tds_read_b128 %10, %17 offset:64\n\tds_read_b128 %11, %17 offset:96\n\t"
                 "ds_read_b128 %12, %17 offset:128\n\tds_read_b128 %13, %17 offset:160\n\tds_read_b128 %14, %17 offset:192\n\tds_read_b128 %15, %17 offset:224\n\ts_waitcnt lgkmcnt(0)"
                 : RD8_OUT(f), RD8_OUT(g) : "v"(a0), "v"(a1) : "memory");
}
template <int S, int H>
__device__ __forceinline__ void lds_tr4(bf16x8 (&f)[4], unsigned addr) {
    s16x4 a0, a1, a2, a3, b0, b1, b2, b3;
    asm volatile("ds_read_b64_tr_b16 %0, %8\n\tds_read_b64_tr_b16 %4, %8 offset:%c9\n\tds_read_b64_tr_b16 %1, %8 offset:%c10\n\tds_read_b64_tr_b16 %5, %8 offset:%c11\n\t"
                 "ds_read_b64_tr_b16 %2, %8 offset:%c12\n\tds_read_b64_tr_b16 %6, %8 offset:%c13\n\tds_read_b64_tr_b16 %3, %8 offset:%c14\n\tds_read_b64_tr_b16 %7, %8 offset:%c15\n\ts_waitcnt lgkmcnt(0)"
                 : "=&v"(a0), "=&v"(a1), "=&v"(a2), "=&v"(a3), "=&v"(b0), "=&v"(b1), "=&v"(b2), "=&v"(b3)
                 : "v"(addr), "i"(H), "i"(S), "i"(S + H), "i"(2 * S), "i"(2 * S + H), "i"(3 * S), "i"(3 * S + H) : "memory");
#define CAT_(lo, hi) __builtin_shufflevector(lo, hi, 0, 1, 2, 3, 4, 5, 6, 7)
    f[0] = CAT_(a0, b0); f[1] = CAT_(a1, b1); f[2] = CAT_(a2, b2); f[3] = CAT_(a3, b3);
#undef CAT_
}

struct RetRegs { u32x4 q1, q2, k1, k2, v1, v2, csa, csb; };
template <bool WITH_Q>
__device__ __forceinline__ void ret_load_qkv(RetRegs& R, const bf16_t* __restrict__ proj, int b, int h, int n, int tid) {
    const int t = tid >> 3, c0 = (tid & 7) * 8;
    const size_t row = (size_t)b * SEQ + n * 64 + t;
    const bf16_t* pr = proj + row * INW + h * 128 + c0;
    if (WITH_Q) {
        R.k1 = __builtin_nontemporal_load((const u32x4*)(pr + 2560)); R.k2 = __builtin_nontemporal_load((const u32x4*)(pr + 2560 + 64));
        R.v1 = __builtin_nontemporal_load((const u32x4*)(pr + 3072)); R.v2 = __builtin_nontemporal_load((const u32x4*)(pr + 3072 + 64));
        R.q1 = __builtin_nontemporal_load((const u32x4*)(pr + 2048)); R.q2 = __builtin_nontemporal_load((const u32x4*)(pr + 2048 + 64));
    } else {
        R.k1 = *(const u32x4*)(pr + 2560); R.k2 = *(const u32x4*)(pr + 2560 + 64);
        R.v1 = *(const u32x4*)(pr + 3072); R.v2 = *(const u32x4*)(pr + 3072 + 64);
    }
}
__device__ __forceinline__ void ret_load_cs(RetRegs& R, const float* __restrict__ rot, int n, int tid) {
    const int t = tid >> 3, c0 = (tid & 7) * 8; const int spos = n * 64 + t;
    const unsigned* cp = (const unsigned*)rot + (size_t)spos * 64 + c0;
    R.csa = *(const u32x4*)cp; R.csb = *(const u32x4*)(cp + 4);
}
template <bool WITH_Q>
__device__ __forceinline__ void ret_load(RetRegs& R, const bf16_t* __restrict__ proj, const float* __restrict__ rot, int b, int h, int n, int tid) {
    ret_load_qkv<WITH_Q>(R, proj, b, h, n, tid); ret_load_cs(R, rot, n, tid);
}
template <bool WITH_Q>
__device__ __forceinline__ void ret_store(const RetRegs& R, LAS unsigned char* lds, float l2g, int tid) {
    const int t = tid >> 3, c0 = (tid & 7) * 8;
    float cs[8], sn[8];
#pragma unroll
    for (int e = 0; e < 4; ++e) { cs[e] = __uint_as_float(R.csa[e] << 16); sn[e] = __uint_as_float(R.csa[e] & 0xffff0000u); cs[4 + e] = __uint_as_float(R.csb[e] << 16); sn[4 + e] = __uint_as_float(R.csb[e] & 0xffff0000u); }
    float a[8], bb[8], o1[8], o2[8];
    unpack8(R.k1, a); unpack8(R.k2, bb);
#pragma unroll
    for (int e = 0; e < 8; ++e) { o1[e] = a[e] * cs[e] - bb[e] * sn[e]; o2[e] = a[e] * sn[e] + bb[e] * cs[e]; }
    LAS unsigned char* rowp = lds + t * RP + c0 * 2;
    LAS unsigned char* rowt = lds + t * RPT + c0 * 2;
    if (WITH_Q) { *(LAS u32x4*)(rowp + R_KS) = packf8(o1); *(LAS u32x4*)(rowp + R_KS + 128) = packf8(o2); }
    const float kd = ex2(l2g * (float)(63 - t));
#pragma unroll
    for (int e = 0; e < 8; ++e) { o1[e] *= kd; o2[e] *= kd; }
    *(LAS u32x4*)(rowt + R_KD) = packf8(o1); *(LAS u32x4*)(rowt + R_KD + 128) = packf8(o2);
    *(LAS u32x4*)(rowt + R_VS) = R.v1; *(LAS u32x4*)(rowt + R_VS + 128) = R.v2;
    if (WITH_Q) {
        unpack8(R.q1, a); unpack8(R.q2, bb);
#pragma unroll
        for (int e = 0; e < 8; ++e) { o1[e] = a[e] * cs[e] - bb[e] * sn[e]; o2[e] = a[e] * sn[e] + bb[e] * cs[e]; }
        *(LAS u32x4*)(rowp + R_QS) = packf8(o1); *(LAS u32x4*)(rowp + R_QS + 128) = packf8(o2);
    }
}
__device__ __forceinline__ void ret_state_update(f32x16 (&accS)[2], LAS const unsigned char* lds, int wid, int lane, float cd) {
    const int hi = lane >> 5, i16 = lane & 15, tq_ = i16 >> 2, tp = i16 & 3, blk = (lane >> 4) & 1;
    const int dvb = wid >> 1, dkb0 = (wid & 1) * 2;
    LAS const unsigned char* nat = lds + (8 * hi + tq_) * RPT + (16 * blk + 4 * tp) * 2;
    bf16x8 va[4], k0[4], k1[4];
    lds_tr4<16 * RPT, 4 * RPT>(va, lds_addr(nat + R_VS + dvb * 64));
    lds_tr4<16 * RPT, 4 * RPT>(k0, lds_addr(nat + R_KD + dkb0 * 64));
    lds_tr4<16 * RPT, 4 * RPT>(k1, lds_addr(nat + R_KD + (dkb0 + 1) * 64));
#pragma unroll
    for (int i = 0; i < 16; ++i) { accS[0][i] *= cd; accS[1][i] *= cd; }
#pragma unroll
    for (int s = 0; s < 4; ++s) { accS[0] = MFMA32(va[s], k0[s], accS[0]); accS[1] = MFMA32(va[s], k1[s], accS[1]); }
}
constexpr int R_GT = R_RED + 1024;
static_assert(R_GT + 64 * RP <= 163840 - 512, "retention LDS");
constexpr int R_MASK = R_GT + 64 * RP;
static_assert(R_MASK + 64 * 272 <= 163840 - 512, "retention LDS");
constexpr int R_IMG = 2 * 64 * RPT;
static_assert(R_IMG + R_VS + 64 * RPT <= 163840 - 512, "retention LDS");
__device__ __forceinline__ void ret_r1_item(const bf16_t* __restrict__ proj, const float* __restrict__ rot, float* __restrict__ Tws, LAS unsigned char* lds, int item, int tid) {
    const int b = item & 7, h = (item >> 3) & 3, seg = item >> 5;
    const int wid = tid >> 6, lane = tid & 63;
    const float l2g = log2gamma(h), cd = ex2(l2g * 64.0f);
    f32x16 accS[2];
#pragma unroll
    for (int i = 0; i < 16; ++i) { accS[0][i] = 0.f; accS[1][i] = 0.f; }
    RetRegs RA, RB;
    ret_load<false>(RA, proj, rot, b, h, seg * 8, tid);
    ret_load<false>(RB, proj, rot, b, h, seg * 8 + 1, tid);
    ret_store<false>(RA, lds, l2g, tid);
    __syncthreads();
#pragma unroll 1
    for (int c = 0; c < 8; c += 2) {
        if (c + 2 < 8) ret_load<false>(RA, proj, rot, b, h, seg * 8 + c + 2, tid);
        ret_state_update(accS, lds, wid, lane, cd);
        ret_store<false>(RB, lds + R_IMG, l2g, tid);
        __syncthreads();
        if (c + 3 < 8) ret_load<false>(RB, proj, rot, b, h, seg * 8 + c + 3, tid);
        ret_state_update(accS, lds + R_IMG, wid, lane, cd);
        if (c + 2 < 8) ret_store<false>(RA, lds, l2g, tid);
        __syncthreads();
    }
    unsigned* tp = (unsigned*)Tws + (size_t)item * 8192 + (size_t)wid * 1024 + lane;
#pragma unroll
    for (int kk = 0; kk < 2; ++kk)
#pragma unroll
        for (int i = 0; i < 8; ++i) tp[(kk * 8 + i) * 64] = cvtpk(accS[kk][2 * i], accS[kk][2 * i + 1]);
}
__device__ __forceinline__ void ret_r2_item(const bf16_t* __restrict__ proj, const float* __restrict__ rot, const float* __restrict__ Tws, bf16_t* __restrict__ y, LAS unsigned char* lds, int item, int tid) {
    const int b = item & 7, h = (item >> 3) & 3, seg = item >> 5;
    const int wid = tid >> 6, lane = tid & 63, r = lane & 31, hi = lane >> 5;
    const int dvb = wid >> 1, ib = wid & 1, dkb0 = (wid & 1) * 2;
    const float l2g = log2gamma(h), cd = ex2(l2g * 64.0f), cd8 = ex2(l2g * 512.0f);
    RetRegs R;
    ret_load<true>(R, proj, rot, b, h, seg * 8, tid);
    f32x16 accS[2];
#pragma unroll
    for (int i = 0; i < 16; ++i) { accS[0][i] = 0.f; accS[1][i] = 0.f; }
    { unsigned tv[7][16];
#pragma unroll
      for (int sp = 0; sp < 7; ++sp) if (sp < seg) {
          const unsigned* tp = (const unsigned*)Tws + (size_t)(b + 8 * h + 32 * sp) * 8192 + (size_t)wid * 1024 + lane;
#pragma unroll
          for (int i = 0; i < 16; ++i) tv[sp][i] = tp[i * 64]; }
#pragma unroll
      for (int sp = 0; sp < 7; ++sp) if (sp < seg) {
          const float w = ex2(l2g * 512.0f * (float)(seg - 1 - sp));
#pragma unroll
          for (int kk = 0; kk < 2; ++kk)
#pragma unroll
              for (int i = 0; i < 8; ++i) { accS[kk][2 * i] += w * __uint_as_float(tv[sp][kk * 8 + i] << 16); accS[kk][2 * i + 1] += w * __uint_as_float(tv[sp][kk * 8 + i] & 0xffff0000u); } } }
    const int i16 = lane & 15, tq_ = i16 >> 2, tp_ = i16 & 3, blk = (lane >> 4) & 1;
    LAS const unsigned char* vperm = lds + R_VS + (4 * hi + tq_) * RPT + (dvb * 32 + 16 * blk + 4 * tp_) * 2;
    LAS float* red = (LAS float*)(lds + R_RED);
    const int itok = ib * 32 + r;
    const float qdec = ex2(l2g * (float)(itok + 1));
    const int gt_t = tid >> 3, gt_c = (tid & 7) * 8;
    u32x4 ga, gb;
    { const bf16_t* gp = proj + ((size_t)b * SEQ + seg * 512 + gt_t) * INW + 3584 + h * 128 + gt_c;
      ga = *(const u32x4*)gp; gb = *(const u32x4*)(gp + 64); }
    LAS unsigned char* gtp = lds + R_GT + gt_t * RP + gt_c * 2;
    { LAS float* mk = (LAS float*)(lds + R_MASK);
      for (int e = tid; e < 64 * 64; e += NTHREADS) { const int i = e >> 6, j = e & 63, d = i - j; mk[i * 68 + j] = ex2(l2g * (float)(d < 0 ? -d : d)); } }
    LAS const float* mrow = (LAS const float*)(lds + R_MASK) + itok * 68 + 4 * hi;
#pragma unroll 1
    for (int c = 0; c < 8; ++c) {
        const int n = seg * 8 + c;
#pragma unroll
        for (int kk = 0; kk < 2; ++kk)
#pragma unroll
            for (int g = 0; g < 4; ++g) { u32x2 w; w.x = cvtpk(accS[kk][4 * g], accS[kk][4 * g + 1]); w.y = cvtpk(accS[kk][4 * g + 2], accS[kk][4 * g + 3]);
                *(LAS u32x2*)(lds + R_ST + ((dkb0 + kk) * 32 + r) * RP + (dvb * 32 + 8 * g + 4 * hi) * 2) = w; }
        ret_store<true>(R, lds, l2g, tid);
        *(LAS u32x4*)gtp = ga; *(LAS u32x4*)(gtp + 128) = gb;
        __syncthreads();
        const size_t row = (size_t)b * SEQ + n * 64 + itok;
        if (c < 7) ret_load_qkv<true>(R, proj, b, h, n + 1, tid);
        bf16x8 qf[8];
        f32x16 a0, a1, o;
#pragma unroll
        for (int i = 0; i < 16; ++i) { a0[i] = 0.f; a1[i] = 0.f; o[i] = 0.f; }
        { bf16x8 kf[8];
          lds_rd16(qf, kf, lds_addr(lds + R_QS + itok * RP + 16 * hi), lds_addr(lds + R_KS + r * RP + 16 * hi));
#pragma unroll
          for (int s = 0; s < 8; ++s) a0 = MFMA32(kf[s], qf[s], a0); }
        { bf16x8 kf[8];
          lds_rd8(kf, lds_addr(lds + R_KS + (32 + r) * RP + 16 * hi));
#pragma unroll
          for (int s = 0; s < 8; ++s) a1 = MFMA32(kf[s], qf[s], a1); }
        { bf16x8 sf[4];
          LAS const unsigned char* snat = lds + R_ST + (8 * hi + tq_) * RP + (dvb * 32 + 16 * blk + 4 * tp_) * 2;
          lds_tr4<16 * RP, 4 * RP>(sf, lds_addr(snat));
#pragma unroll
          for (int s = 0; s < 4; ++s) o = MFMA32(sf[s], qf[s], o);
          lds_tr4<16 * RP, 4 * RP>(sf, lds_addr(snat + 64 * RP));
#pragma unroll
          for (int s = 0; s < 4; ++s) o = MFMA32(sf[s], qf[4 + s], o); }
        if (c < 7) ret_load_cs(R, rot, n + 1, tid);
#pragma unroll
        for (int g = 0; g < 4; ++g) { const f32x4 m0 = *(LAS const f32x4*)(mrow + 8 * g), m1 = *(LAS const f32x4*)(mrow + 32 + 8 * g);
#pragma unroll
            for (int e = 0; e < 4; ++e) { a0[4 * g + e] *= m0[e]; a1[4 * g + e] *= m1[e]; } }
#pragma unroll
        for (int i = 0; i < 16; ++i) o[i] *= qdec;
        { const bf16x8 p00 = pack8(a0, 0), p01 = pack8(a0, 1), p10 = pack8(a1, 0), p11 = pack8(a1, 1);
          bf16x8 vf[4]; lds_tr4<16 * RPT, 8 * RPT>(vf, lds_addr(vperm));
          o = MFMA32(vf[0], p00, o); o = MFMA32(vf[1], p01, o); o = MFMA32(vf[2], p10, o); o = MFMA32(vf[3], p11, o); }
        ret_state_update(accS, lds, wid, lane, cd);
        { const bf16_t* gp = proj + ((size_t)b * SEQ + (n + (c < 7 ? 1 : 0)) * 64 + gt_t) * INW + 3584 + h * 128 + gt_c;
          ga = *(const u32x4*)gp; gb = *(const u32x4*)(gp + 64); }
        float ss = 0.f;
#pragma unroll
        for (int i = 0; i < 16; ++i) ss += o[i] * o[i];
        ss += __shfl_xor(ss, 32);
        if (hi == 0) red[dvb * 64 + itok] = ss;
        __syncthreads();
        const float tot = (red[itok] + red[64 + itok]) + (red[128 + itok] + red[192 + itok]);
        const float rstd = __builtin_amdgcn_rsqf(tot * (1.0f / RD) + EPS);
        { LAS unsigned char* op = lds + R_GT + itok * RP + (dvb * 32 + 4 * hi) * 2;
#pragma unroll
          for (int g = 0; g < 4; ++g) { const u32x2 gv = *(LAS const u32x2*)(op + 16 * g); u32x2 w;
              w.x = cvtpk(o[4 * g] * rstd * bf2f((unsigned short)(gv.x & 0xffff)), o[4 * g + 1] * rstd * bf2f((unsigned short)(gv.x >> 16)));
              w.y = cvtpk(o[4 * g + 2] * rstd * bf2f((unsigned short)(gv.y & 0xffff)), o[4 * g + 3] * rstd * bf2f((unsigned short)(gv.y >> 16)));
              *(LAS u32x2*)(op + 16 * g) = w; } }
        __syncthreads();
        { bf16_t* yp = y + ((size_t)b * SEQ + n * 64 + gt_t) * DM + 512 + h * 128 + gt_c;
          *(u32x4*)yp = *(LAS const u32x4*)gtp; *(u32x4*)(yp + 64) = *(LAS const u32x4*)(gtp + 128); }
    }
    __syncthreads();
}

constexpr size_t WS_CTL = 40 * MiB;
constexpr size_t CTL_ZERO_BYTES = 16384;
constexpr int MISC_OFF = 163840 - 256;
#define XB_TMO      128
#define XB_XCNT(j)  (256  + 64 * (j))
#define XB_XSUB(j)  (1280 + 64 * (j))
#define XB_XGEN(j)  (2304 + 64 * (j))
#define XB_TOP      3328
#define XB_TOPGEN   3392
#define XCD_BAR_WORDS 3456
#define XB_SPIN_CAP (1u << 18)

__device__ __forceinline__ unsigned xb_ld(unsigned* p)              { return __hip_atomic_load(p, __ATOMIC_RELAXED, __HIP_MEMORY_SCOPE_AGENT); }
__device__ __forceinline__ unsigned xb_add(unsigned* p, unsigned v) { return __hip_atomic_fetch_add(p, v, __ATOMIC_RELAXED, __HIP_MEMORY_SCOPE_AGENT); }
__device__ __forceinline__ unsigned xb_xcc_id() { return (unsigned)__builtin_amdgcn_s_getreg((3 << 11) | 20) & 0xFu; }
#define XB_SPIN(cond, bar) do { unsigned _sp = 0; while (cond) { __builtin_amdgcn_s_sleep(1); \
    if ((++_sp & 255u) == 0u) { if (xb_ld(&(bar)[XB_TMO])) break; if (_sp > XB_SPIN_CAP) { atomicAdd(&(bar)[XB_TMO], 1u); break; } } } } while (0)

struct XcdBarrier {
    unsigned* bar; unsigned x;
    volatile LAS unsigned* st;
};

__device__ __forceinline__ XcdBarrier xcd_barrier_post(unsigned* bar, volatile LAS unsigned* st) {
    XcdBarrier b; b.bar = bar; b.x = xb_xcc_id(); b.st = st;
    if (threadIdx.x == 0) (void)xb_add(&bar[XB_XCNT(b.x)], 1u);
    return b;
}
__device__ __forceinline__ void xcd_barrier_complete(unsigned* bar, unsigned x, unsigned& nloc, unsigned& nx) {
    const unsigned G = gridDim.x * gridDim.y * gridDim.z;
    unsigned sum, cnt, mine, sp = 0u;
    for (;;) {
        sum = 0u; cnt = 0u; mine = 0u;
#pragma unroll
        for (unsigned j = 0; j < 16; ++j) { const unsigned c = xb_ld(&bar[XB_XCNT(j)]); sum += c; cnt += (c > 0u) ? 1u : 0u; mine = (j == x) ? c : mine; }
        if (sum == G) break;
        __builtin_amdgcn_s_sleep(1);
        if ((++sp & 255u) == 0u) { if (xb_ld(&bar[XB_TMO])) break; if (sp > XB_SPIN_CAP) { atomicAdd(&bar[XB_TMO], 1u); break; } }
    }
    nloc = mine > 0u ? mine : 1u; nx = cnt > 0u ? cnt : 1u;
}

__device__ __forceinline__ void xcd_barrier(const XcdBarrier& b) {
    asm volatile("s_waitcnt vmcnt(0)" ::: "memory");
    __syncthreads();
    if (threadIdx.x == 0) {
        unsigned* bar = b.bar;
        __builtin_amdgcn_s_waitcnt(0);
        unsigned nloc = b.st[0], nx = b.st[1];
        if (nloc == 0u) { xcd_barrier_complete(bar, b.x, nloc, nx); b.st[0] = nloc; b.st[1] = nx; }
        const unsigned old = xb_add(&bar[XB_XSUB(b.x)], 1u);
        const unsigned gen = old / nloc;
        if (old + 1u == (gen + 1u) * nloc) {
            __builtin_amdgcn_fence(__ATOMIC_RELEASE, "agent");
            asm volatile("s_waitcnt vmcnt(0)" ::: "memory");
            const unsigned og = xb_add(&bar[XB_TOP], 1u);
            const unsigned tg = og / nx;
            if (og + 1u == (tg + 1u) * nx) xb_add(&bar[XB_TOPGEN], 1u);
            else XB_SPIN(xb_ld(&bar[XB_TOPGEN]) == tg, bar);
            __builtin_amdgcn_fence(__ATOMIC_ACQUIRE, "agent");
            xb_add(&bar[XB_XGEN(b.x)], 1u);
            asm volatile("s_waitcnt vmcnt(0)" ::: "memory");
        } else {
            XB_SPIN(xb_ld(&bar[XB_XGEN(b.x)]) == gen, bar);
            __builtin_amdgcn_fence(__ATOMIC_ACQUIRE, "agent");
            asm volatile("s_waitcnt vmcnt(0)" ::: "memory");
        }
    }
    __syncthreads();
}


constexpr int N_PHASES = 10;
#ifndef DUP_PHASE
#define DUP_PHASE -1
#endif
#ifdef PROBE_DOUBLE_BARRIER
#define BAR_EXTRA(b) xcd_barrier(b);
#else
#define BAR_EXTRA(b)
#endif
#ifdef PROBE_STAMP
#define STAMP_DECL unsigned long long st_t0_ = (PROBE_STAMP == 0) ? __builtin_amdgcn_s_memrealtime() : 0ull, st_t1_ = 0;
#define STAMP_AT(k) if ((k) + 1 == PROBE_STAMP) { st_t0_ = __builtin_amdgcn_s_memrealtime(); } if ((k) == PROBE_STAMP) { st_t1_ = __builtin_amdgcn_s_memrealtime(); }
#define STAMP_END if (PROBE_STAMP == 9) st_t1_ = __builtin_amdgcn_s_memrealtime(); if (blockIdx.x == 0) { const unsigned long long d_ = (st_t1_ - st_t0_) * 8ull; const unsigned long long s_ = __builtin_amdgcn_s_memrealtime(); while (__builtin_amdgcn_s_memrealtime() - s_ < d_) __builtin_amdgcn_s_sleep(8); }
#else
#define STAMP_DECL
#define STAMP_AT(k)
#define STAMP_END
#endif
#define REPS(code) for (int rep_ = 0; rep_ < ((DUP_PHASE == (code)) ? 2 : 1); ++rep_)
__global__ void __launch_bounds__(NTHREADS, 2) mega(Args a) {
    extern __shared__ __attribute__((aligned(16))) unsigned char lds_raw[];
    LAS unsigned char* lds = (LAS unsigned char*)lds_raw;
    const int G = gridDim.x, bx = blockIdx.x;
#define PHASE_IDS int tid = threadIdx.x; asm volatile("" : "+v"(tid)); const int lane = tid & 63, wid = __builtin_amdgcn_readfirstlane(tid >> 6); const int gw = bx * NWAVES + wid, NGW = G * NWAVES; (void)lane; (void)gw; (void)NGW;
    unsigned char* ws = a.ws;
#define PHASE_PTRS __attribute__((address_space(1))) unsigned char* wsp_g = (__attribute__((address_space(1))) unsigned char*)a.ws; asm volatile("" : "+s"(wsp_g)); unsigned char* wsp = (unsigned char*)wsp_g;     bf16_t* Win_t = (bf16_t*)(wsp + WS_WIN); bf16_t* Wout_t = (bf16_t*)(wsp + WS_WOUT); \
    float* rot = (float*)(wsp + WS_ROT); float* Tws = (float*)(wsp + WS_T); bf16_t* hb = (bf16_t*)(wsp + WS_HB); bf16_t* proj = (bf16_t*)(wsp + WS_PROJ); \
    bf16_t* xb = (bf16_t*)(wsp + WS_XB); float* ssq = (float*)(wsp + WS_SSQ); (void)xb; (void)ssq; \
    (void)Win_t; (void)Wout_t; (void)rot; (void)Tws; (void)hb; (void)proj;
    const int lo = a.ph_lo, hi_ = a.ph_hi;
    STAMP_DECL
    volatile LAS unsigned* MISC = (volatile LAS unsigned*)(lds + MISC_OFF);
    if (threadIdx.x < 32) MISC[threadIdx.x] = 0u;
    __syncthreads();
    if (hi_ - lo > 1) (void)xcd_barrier_post((unsigned*)(ws + WS_CTL), MISC + 8);
#ifdef ONLY_PH
#define IN(k) ((((k) == 0 ? 0 : ((k) == 9 ? 5 : ((k) - 1) % 4 + 1)) == ONLY_PH) && lo <= (k) && (k) < hi_)
#else
#define IN(k) (lo <= (k) && (k) < hi_)
#endif
#define SEAM(k) do { if (IN(k) && IN((k) + 1)) { XcdBarrier bb_; bb_.bar = (unsigned*)(a.ws + WS_CTL); bb_.x = xb_xcc_id(); bb_.st = (volatile LAS unsigned*)(lds + MISC_OFF) + 8; xcd_barrier(bb_); BAR_EXTRA(bb_) } STAMP_AT(k) } while (0)

    if (IN(0)) {
        PHASE_IDS PHASE_PTRS
        REPS(0) {
        { f32x4 va[4][4], vb[4][4];
          const int st = NGW * 4; int m = gw * 4;
          if (m < MTOK) rows_load<4>(va, a.x + (size_t)m * DM, lane);
          while (m < MTOK) {
              if (m + st < MTOK) rows_load<4>(vb, a.x + (size_t)(m + st) * DM, lane);
              rows_finish<4>(va, xb + (size_t)m * DM, ssq + m, lane);
              m += st; if (m >= MTOK) break;
              if (m + st < MTOK) rows_load<4>(va, a.x + (size_t)(m + st) * DM, lane);
              rows_finish<4>(vb, xb + (size_t)m * DM, ssq + m, lane);
              m += st; } }
        LAS float* scr = (LAS float*)(lds + wid * 16384);
        constexpr int I_IN = (DM / 64) * (INW / 32), I_OUT = (DM / 64) * (DM / 32), I_L = I_IN + I_OUT;
        for (int it = gw; it < DEPTH * I_L; it += NGW) {
            const int l = it / I_L, r = it % I_L;
            if (r < I_IN) transpose_item(a.win + (size_t)l * DM * INW, a.ng + (size_t)l * DM, DM, INW, Win_t + (size_t)l * INW * DM, scr, r, lane);
            else transpose_item(a.wout + (size_t)l * DM * DM, nullptr, DM, DM, Wout_t + (size_t)l * DM * DM, scr, r - I_IN, lane);
        }
        for (int idx = bx * NTHREADS + tid; idx < SEQ * 64; idx += G * NTHREADS) { float c, s; rot_entry(a.pos[idx >> 6], idx & 63, c, s); ((unsigned*)rot)[idx] = cvtpk(c, s); }
        for (int m = bx * NTHREADS + tid; m < 2 * MTOK; m += G * NTHREADS) ssq[MTOK + m] = 0.f;
        }
    }
    SEAM(0);
#pragma unroll
    for (int l = 0; l < DEPTH; ++l) {
        const int p0 = 4 * l;
        if (IN(p0 + 1)) {
            PHASE_PTRS
            pg8::Gemm g{xb, Win_t + (size_t)l * INW * DM, MTOK, INW, DM}; pg8::StaticOrder S; S.init(MTOK, INW, G, bx);
            EpiProj E{proj, ssq + (size_t)l * MTOK};
            REPS(l == 0 ? 1 : 100) pg8::gemm_phase<EpiProj, pg8::StaticOrder, PG8_ALIGN, PG8_SP2>(lds, g, S, E);
        }
        SEAM(p0 + 1);
        if (IN(p0 + 2)) {
            PHASE_IDS PHASE_PTRS
            REPS(l == 0 ? 21 : 100) for (int item = bx; item < 256; item += G) ret_r1_item(proj, rot, Tws, lds, item, tid);
            const float* relb = a.relb + (size_t)l * AH * NREL;
            REPS(l == 0 ? 22 : 100) attn_block_units(proj, hb, relb, lds, bx, G, tid);
        }
        SEAM(p0 + 2);
        if (IN(p0 + 3)) {
            PHASE_IDS PHASE_PTRS
            REPS(l == 0 ? 3 : 100) for (int item = bx; item < 256; item += G) ret_r2_item(proj, rot, Tws, hb, lds, item, tid);
        }
        SEAM(p0 + 3);
        if (IN(p0 + 4)) {
            PHASE_PTRS
            pg8::Gemm g{hb, Wout_t + (size_t)l * DM * DM, MTOK, DM, DM}; pg8::StaticOrder S; S.init(MTOK, DM, G, bx);
            EpiRes E{xb, ssq + (size_t)(l + 1) * MTOK};
            pg8::gemm_phase<EpiRes, pg8::StaticOrder, PG8_ALIGN, PG8_SP2>(lds, g, S, E);
        }
        SEAM(p0 + 4);
    }
    if (IN(9)) {
        PHASE_IDS PHASE_PTRS
        for (int m = gw * 4; m < MTOK; m += NGW * 4) rms_rows4_final(xb + (size_t)m * DM, ssq + (size_t)DEPTH * MTOK + m, a.fg, a.out + (size_t)m * DM, lane);
    }
    STAMP_END
#undef IN
#undef SEAM
}

extern "C" void kernel_launch(void* const* d_in, const int* in_sizes, int n_in, void* d_out, int out_size, void* d_ws, size_t ws_size, hipStream_t stream) {
    static int grid = 0;
    if (grid == 0) {
        int dev = 0, cus = 0, per_cu = 0;
        hipGetDevice(&dev);
        hipDeviceGetAttribute(&cus, hipDeviceAttributeMultiprocessorCount, dev);
        if (hipFuncSetAttribute((const void*)mega, hipFuncAttributeMaxDynamicSharedMemorySize, LDS_BYTES) != hipSuccess) fprintf(stderr, "kernel_launch: hipFuncSetAttribute failed\n");
        if (hipOccupancyMaxActiveBlocksPerMultiprocessor(&per_cu, (const void*)mega, NTHREADS, LDS_BYTES) != hipSuccess || per_cu < 1) { fprintf(stderr, "kernel_launch: occupancy query says %d\n", per_cu); per_cu = 1; }
        (void)hipGetLastError();
        grid = cus * per_cu;
        if (ws_size < WS_END) fprintf(stderr, "kernel_launch: workspace too small: %zu < %zu\n", ws_size, (size_t)WS_END);
    }
    Args a{};
    a.x = (const float*)d_in[0]; a.pos = (const int*)d_in[1]; a.ng = (const float*)d_in[2]; a.win = (const float*)d_in[3]; a.wout = (const float*)d_in[4];
    a.relb = (const float*)d_in[5]; a.fg = (const float*)d_in[6]; a.out = (float*)d_out; a.ws = (unsigned char*)d_ws;
#if MK_MULTI
    for (int ph = 0; ph < N_PHASES; ++ph) { a.ph_lo = ph; a.ph_hi = ph + 1; hipLaunchKernelGGL(mega, dim3(grid), dim3(NTHREADS), LDS_BYTES, stream, a); }
#else
    a.ph_lo = 0; a.ph_hi = N_PHASES;
    if (hipMemsetAsync((char*)d_ws + WS_CTL, 0, CTL_ZERO_BYTES, stream) != hipSuccess) { fprintf(stderr, "kernel_launch: memset failed\n"); return; }
    hipLaunchKernelGGL(mega, dim3(grid), dim3(NTHREADS), LDS_BYTES, stream, a);
#ifdef PROBE_EXTRA_PHASE
    a.out = (float*)((char*)d_ws + 384 * MiB); a.ph_lo = PROBE_EXTRA_PHASE; a.ph_hi = PROBE_EXTRA_PHASE + 1; hipLaunchKernelGGL(mega, dim3(grid), dim3(NTHREADS), LDS_BYTES, stream, a);
#endif
#endif
}
```
